# Optimizing an MI355X kernel written in HIP

```python
import math
import jax, jax.numpy as jnp
from jax import lax
import numpy as np

D_MODEL = 4096
BATCH = 1
SEQ = 8192
DEPTH = 2

GRID_W = 64
Q_BLOCK = 128
EPS = 1e-6

A_HEAD_DIM = 128
A_HEADS = 3 * D_MODEL // (8 * A_HEAD_DIM)
A_KV_HEADS = A_HEADS // 3
A_ROPE_THETA = 10000.0

B_QK_DIM = 64
B_V_DIM = 2 * B_QK_DIM
B_HEADS = D_MODEL // (4 * B_V_DIM)
B_ROPE_DIM = B_QK_DIM // 4
ROPE_THETA = 500000.0

C_V_DIM = 128
C_HEADS = 3 * D_MODEL // (8 * C_V_DIM)
C_Q_LORA = D_MODEL // 4
C_KV_LORA = D_MODEL // 8
C_NOPE = 128
C_ROPE = 64
C_QK_DIM = C_NOPE + C_ROPE
C_ROPE_THETA = 10000.0

MIX_WIDTH = A_HEADS * A_HEAD_DIM + B_HEADS * B_V_DIM + C_HEADS * C_V_DIM

IN_SPLITS = (
    A_HEADS * A_HEAD_DIM,
    A_KV_HEADS * A_HEAD_DIM,
    A_KV_HEADS * A_HEAD_DIM,
    B_HEADS * 2 * B_QK_DIM,
    B_HEADS * 2 * B_QK_DIM,
    B_HEADS * B_V_DIM,
    C_Q_LORA,
    C_KV_LORA,
    C_ROPE,
)
N_IN = sum(IN_SPLITS)

FFN_HIDDEN = -(-8 * D_MODEL // (3 * 256)) * 256

kernel_name = "hybrid_parallel_gqa_diff_mla_encoder"


def rmsnorm(x, g):
    xf = x.astype(jnp.float32)
    y = xf * lax.rsqrt(jnp.mean(xf * xf, axis=-1, keepdims=True) + EPS) * g.astype(jnp.float32)
    return y.astype(x.dtype)


def rope_table(pos, dim, theta):
    inv = theta ** (-jnp.arange(0, dim, 2, dtype=jnp.float32) / dim)
    ang = pos.astype(jnp.float32)[:, None] * inv[None, :]
    return jnp.cos(ang), jnp.sin(ang)


def apply_rope(x, tab):
    cos, sin = tab
    n = cos.shape[-1]
    c = cos[:, None, :]
    s = sin[:, None, :]
    x1 = x[..., :n].astype(jnp.float32)
    x2 = x[..., n:].astype(jnp.float32)
    return jnp.concatenate([x1 * c - x2 * s, x2 * c + x1 * s], axis=-1).astype(x.dtype)


def to_blocks(t):
    b, s = t.shape[:2]
    return jnp.moveaxis(t.reshape(b, s // Q_BLOCK, Q_BLOCK, *t.shape[2:]), 1, 0)


def from_blocks(t):
    t = jnp.moveaxis(t, 0, 1)
    return t.reshape(t.shape[0], t.shape[1] * t.shape[2], *t.shape[3:])


def gqa_attention(q, k, v, scale):
    b, s, h, d = q.shape
    hk = k.shape[2]
    qb = to_blocks(q.reshape(b, s, hk, h // hk, d))

    def one_block(qblk):
        sc = jnp.einsum('bqhgd,bkhd->bhgqk', qblk, k).astype(jnp.float32) * scale
        p = jax.nn.softmax(sc, axis=-1).astype(v.dtype)
        return jnp.einsum('bhgqk,bkhe->bqhge', p, v)

    o = from_blocks(lax.map(one_block, qb))
    return o.reshape(b, s, h, v.shape[-1])


def diff_attention(q, k, v, lam, scale):
    qb = to_blocks(q)

    def one_block(qblk):
        sc = jnp.einsum('bqhmd,bkhmd->bhmqk', qblk, k).astype(jnp.float32) * scale
        p = jax.nn.softmax(sc, axis=-1)
        a = (p[:, :, 0] - lam * p[:, :, 1]).astype(v.dtype)
        return jnp.einsum('bhqk,bkhe->bqhe', a, v)

    return from_blocks(lax.map(one_block, qb))


def mixer_a(aq, ak, av, q_norm, k_norm, row_tab, col_tab):
    b, s, _ = aq.shape
    q = rmsnorm(aq.reshape(b, s, A_HEADS, A_HEAD_DIM), q_norm)
    k = rmsnorm(ak.reshape(b, s, A_KV_HEADS, A_HEAD_DIM), k_norm)
    v = av.reshape(b, s, A_KV_HEADS, A_HEAD_DIM)
    half = A_HEAD_DIM // 2
    q = jnp.concatenate([apply_rope(q[..., :half], row_tab), apply_rope(q[..., half:], col_tab)], axis=-1)
    k = jnp.concatenate([apply_rope(k[..., :half], row_tab), apply_rope(k[..., half:], col_tab)], axis=-1)
    o = gqa_attention(q, k, v, 1.0 / math.sqrt(A_HEAD_DIM))
    return o.reshape(b, s, A_HEADS * A_HEAD_DIM)


def mixer_b(bq, bk, bv, q_norm, k_norm, lam_p, subln, lambda_init, tab):
    b, s, _ = bq.shape

    def prep(t, g):
        t = rmsnorm(t.reshape(b, s, B_HEADS * 2, B_QK_DIM), g)
        t = jnp.concatenate([apply_rope(t[..., :B_ROPE_DIM], tab), t[..., B_ROPE_DIM:]], axis=-1)
        return t.reshape(b, s, B_HEADS, 2, B_QK_DIM)

    q = prep(bq, q_norm)
    k = prep(bk, k_norm)
    v = bv.reshape(b, s, B_HEADS, B_V_DIM)
    lp = lam_p.astype(jnp.float32)
    lam = jnp.exp(jnp.sum(lp[0] * lp[1])) - jnp.exp(jnp.sum(lp[2] * lp[3])) + lambda_init
    o = diff_attention(q, k, v, lam, 1.0 / math.sqrt(B_QK_DIM))
    o = rmsnorm(o, subln) * (1.0 - lambda_init)
    return o.reshape(b, s, B_HEADS * B_V_DIM)


def mixer_c(cql, ckvl, ckr, q_a_norm, kv_a_norm, w_q_up, w_kv_up, q_norm, k_norm, tab):
    b, s, _ = cql.shape
    q = (rmsnorm(cql, q_a_norm) @ w_q_up).reshape(b, s, C_HEADS, C_QK_DIM)
    kv = (rmsnorm(ckvl, kv_a_norm) @ w_kv_up).reshape(b, s, C_HEADS, C_NOPE + C_V_DIM)
    k_nope, v = kv[..., :C_NOPE], kv[..., C_NOPE:]
    k_rope = jnp.broadcast_to(ckr[:, :, None, :], (b, s, C_HEADS, C_ROPE))
    k = jnp.concatenate([k_nope, k_rope], axis=-1)
    q = rmsnorm(q, q_norm)
    k = rmsnorm(k, k_norm)
    q = jnp.concatenate([q[..., :C_NOPE], apply_rope(q[..., C_NOPE:], tab)], axis=-1)
    k = jnp.concatenate([k[..., :C_NOPE], apply_rope(k[..., C_NOPE:], tab)], axis=-1)
    o = gqa_attention(q, k, v, 1.0 / math.sqrt(C_QK_DIM))
    return o.reshape(b, s, C_HEADS * C_V_DIM)


def swiglu(x, w_gate, w_up, w_down):
    return (jax.nn.silu(x @ w_gate) * (x @ w_up)) @ w_down


def setup_inputs(seed: int = 0) -> dict:
    key = jax.random.key(seed)
    ks = jax.random.split(key, 24)
    L, D, F = DEPTH, D_MODEL, FFN_HIDDEN

    def nrm(k, shape, scale):
        return jax.random.normal(k, shape, jnp.float32) * scale

    def gain(k, shape):
        return 1.0 + 0.02 * jax.random.normal(k, shape, jnp.float32)

    return {
        "x": nrm(ks[0], (BATCH, SEQ, D), 1.0),
        "attn_norm": gain(ks[1], (L, D)),
        "w_in": nrm(ks[2], (L, D, N_IN), D ** -0.5),
        "a_q_norm": gain(ks[3], (L, A_HEAD_DIM)),
        "a_k_norm": gain(ks[4], (L, A_HEAD_DIM)),
        "b_q_norm": gain(ks[5], (L, B_QK_DIM)),
        "b_k_norm": gain(ks[6], (L, B_QK_DIM)),
        "b_lambda": nrm(ks[7], (L, 4, B_QK_DIM), 0.1),
        "b_subln": gain(ks[8], (L, B_V_DIM)),
        "c_q_a_norm": gain(ks[9], (L, C_Q_LORA)),
        "c_kv_a_norm": gain(ks[10], (L, C_KV_LORA)),
        "c_w_q_up": nrm(ks[11], (L, C_Q_LORA, C_HEADS * C_QK_DIM), C_Q_LORA ** -0.5),
        "c_w_kv_up": nrm(ks[12], (L, C_KV_LORA, C_HEADS * (C_NOPE + C_V_DIM)), C_KV_LORA ** -0.5),
        "c_q_norm": gain(ks[13], (L, C_QK_DIM)),
        "c_k_norm": gain(ks[14], (L, C_QK_DIM)),
        "w_out": nrm(ks[15], (L, MIX_WIDTH, D), MIX_WIDTH ** -0.5),
        "ffn_norm": gain(ks[16], (L, D)),
        "w_gate": nrm(ks[17], (L, D, F), D ** -0.5),
        "w_up": nrm(ks[18], (L, D, F), D ** -0.5),
        "w_down": nrm(ks[19], (L, F, D), F ** -0.5),
    }


def reference(x, attn_norm, w_in, a_q_norm, a_k_norm, b_q_norm, b_k_norm, b_lambda, b_subln,
              c_q_a_norm, c_kv_a_norm, c_w_q_up, c_w_kv_up, c_q_norm, c_k_norm, w_out,
              ffn_norm, w_gate, w_up, w_down):
    b, s, _ = x.shape
    rows = s // GRID_W
    t = jnp.arange(s, dtype=jnp.int32)
    row_idx = jnp.repeat(jnp.arange(rows, dtype=jnp.int32), GRID_W)
    col_idx = jnp.tile(jnp.arange(GRID_W, dtype=jnp.int32), rows)
    row_tab = rope_table(row_idx, A_HEAD_DIM // 2, A_ROPE_THETA)
    col_tab = rope_table(col_idx, A_HEAD_DIM // 2, A_ROPE_THETA)
    b_tab = rope_table(t, B_ROPE_DIM, ROPE_THETA)
    c_tab = rope_table(t, C_ROPE, C_ROPE_THETA)
    split_points = [int(p) for p in np.cumsum(IN_SPLITS)[:-1]]

    h = x
    for l in range(DEPTH):
        lambda_init = 0.8 - 0.6 * math.exp(-0.3 * l)
        xn = rmsnorm(h, attn_norm[l])
        proj = xn @ w_in[l]
        aq, ak, av, bq, bk, bv, cql, ckvl, ckr = jnp.split(proj, split_points, axis=-1)
        ya = mixer_a(aq, ak, av, a_q_norm[l], a_k_norm[l], row_tab, col_tab)
        yb = mixer_b(bq, bk, bv, b_q_norm[l], b_k_norm[l], b_lambda[l], b_subln[l], lambda_init, b_tab)
        yc = mixer_c(cql, ckvl, ckr, c_q_a_norm[l], c_kv_a_norm[l], c_w_q_up[l], c_w_kv_up[l],
                     c_q_norm[l], c_k_norm[l], c_tab)
        h = h + jnp.concatenate([ya, yb, yc], axis=-1) @ w_out[l]
        h = h + swiglu(rmsnorm(h, ffn_norm[l]), w_gate[l], w_up[l], w_down[l])
    return h
```

```cpp
#include <hip/hip_runtime.h>
#include <cstdio>
#include <cstdint>
namespace pg8 {
#define PG8_LAS __attribute__((address_space(3)))
typedef unsigned short bf16_t;
typedef short bf16x8 __attribute__((ext_vector_type(8)));
typedef float f32x4 __attribute__((ext_vector_type(4)));
typedef unsigned u32x4 __attribute__((ext_vector_type(4)));
constexpr int BM = 256, BK = 64, HALF = 128, HTB = HALF * BK * 2  , STAGE_BYTES = 8 * HTB, NXCD = 8, WGM = 8;

__host__ __device__ __forceinline__ int lds_byte(int r, int c) { const int st = (r >> 4) * 2 + (c >> 5), rr = r & 15, cc = c & 31, ob = rr * 64 + cc * 2; return st * 1024 + (ob ^ (((ob >> 9) & 1) << 5)); }
__host__ __device__ __forceinline__ void stage_rc(int b, int& R, int& C) { const int st = b / 1024, sb = b % 1024, swz = sb ^ (((sb >> 9) & 1) << 5); R = (st >> 1) * 16 + swz / 64; C = (st & 1) * 32 + (swz % 64) / 2; }
__host__ __device__ __forceinline__ int perm32(int rho) { const int n = rho >> 4, i = rho & 15; return 8 * (i >> 2) + 4 * n + (i & 3); }

struct Unit { int pm, pn; };
struct Gemm { const bf16_t* A; const bf16_t* Bt; int M, N, K; };

struct StaticOrder {
    int nM, nN, nwg, G, c;
    __host__ __device__ void init(int M, int N, int G_, int c_) { nM = M / BM; nN = N / BM; nwg = nM * nN; G = G_; c = c_; }
    __host__ __device__ bool next(int i, Unit& u) const {
        const long L = (long)i * G + c; if (L >= nwg) return false;
        int wgid = (int)L; { const int q = nwg / NXCD, r = nwg % NXCD, xcd = wgid % NXCD, off = wgid / NXCD; wgid = (xcd < r ? xcd * (q + 1) : r * (q + 1) + (xcd - r) * q) + off; }
        const int nig = WGM * nN, gid = wgid / nig, fm = gid * WGM, gsz = (nM - fm) < WGM ? (nM - fm) : WGM;
        u.pm = fm + ((wgid % nig) % gsz); u.pn = (wgid % nig) / gsz; return true;
    }
    __device__ __forceinline__ void a_ready(const Unit&) const {}
    __device__ __forceinline__ void done(const Unit&) const {}
};

template <class Epi, class Sched, bool ALIGN_EPI = false, bool SP2 = false>
__device__ __forceinline__ void gemm_phase(PG8_LAS unsigned char* lds, const Gemm g, const Sched& S, const Epi& E) {
    int tid_ = threadIdx.x; asm volatile("" : "+v"(tid_));
    const int tid = tid_, wid = __builtin_amdgcn_readfirstlane(tid >> 6), lane = tid & 63, wr = wid >> 2, wc = wid & 3, fr = lane & 15, fq = lane >> 4;
    const int K = g.K, nt = K / BK;
    unsigned voffA[2], voffB[2];
#pragma unroll
    for (int i = 0; i < 2; ++i) { int R, C; stage_rc(tid * 16 + i * 8192, R, C); const int Rb = Epi::PERM ? ((R & ~31) + perm32(R & 31)) : R;
        voffA[i] = (unsigned)(R * K + C) * 2u; voffB[i] = (unsigned)(Rb * K + C) * 2u; }
    const size_t kstep = (size_t)(BK * 2);
    const size_t hstep = (size_t)HALF * K * 2;
    const size_t tstep = 2 * hstep;
    const unsigned ldsw = (unsigned)wid * 1024u;
    const int aoff = lds_byte(wr * 64 + fr, fq * 8), boff = lds_byte(wc * 32 + fr, fq * 8);
#define PG8_SA(b, h) (((b) * 2 + (h)) * HTB)
#define PG8_SB(b, h) ((4 + (b) * 2 + (h)) * HTB)
#define PG8_STAGE(bufoff, gbase, voff) do { _Pragma("unroll") for (int _i = 0; _i < 2; ++_i) \
        __builtin_amdgcn_global_load_lds((const unsigned*)((const char*)(gbase) + (voff)[_i]), (PG8_LAS unsigned*)(lds + (bufoff) + ldsw + _i * 8192), 16, 0, 0); } while (0)
#define PG8_LDA(dst, b, h) do { _Pragma("unroll") for (int m = 0; m < 4; ++m) _Pragma("unroll") for (int k = 0; k < 2; ++k) dst[m][k] = *(const PG8_LAS bf16x8*)(lds + PG8_SA(b, h) + aoff + m * 2048 + k * 1024); } while (0)
#define PG8_LDB(dst, b, h) do { _Pragma("unroll") for (int n = 0; n < 2; ++n) _Pragma("unroll") for (int k = 0; k < 2; ++k) dst[n][k] = *(const PG8_LAS bf16x8*)(lds + PG8_SB(b, h) + boff + n * 2048 + k * 1024); } while (0)
#define PG8_MMA(ai, bj, At, Bt) do { __builtin_amdgcn_s_setprio(1); _Pragma("unroll") for (int m = 0; m < 4; ++m) _Pragma("unroll") for (int n = 0; n < 2; ++n) _Pragma("unroll") for (int k = 0; k < 2; ++k) \
        acc[ai][bj][m][n] = __builtin_amdgcn_mfma_f32_16x16x32_bf16(Bt[n][k], At[m][k], acc[ai][bj][m][n], 0, 0, 0); __builtin_amdgcn_s_setprio(0); } while (0)
#define PG8_WAIT_V(n) asm volatile("s_waitcnt vmcnt(" #n ")" ::: "memory")
#define PG8_WAIT_L(n) asm volatile("s_waitcnt lgkmcnt(" #n ")" ::: "memory")
#define PG8_BAR __builtin_amdgcn_s_barrier()
#define PG8_SCHED __builtin_amdgcn_sched_barrier(0)
    Unit cur, nxt; int ui = 0;
    if (!S.next(0, cur)) return;
    f32x4 acc[2][2][4][2];
#pragma unroll
    for (int a = 0; a < 2; ++a)
#pragma unroll
        for (int b = 0; b < 2; ++b)
#pragma unroll
            for (int m = 0; m < 4; ++m)
#pragma unroll
                for (int n = 0; n < 2; ++n) acc[a][b][m][n] = (f32x4){0.f, 0.f, 0.f, 0.f};
    bf16x8 At[4][2], B0[2][2], B1[2][2];
    const char* cA = (const char*)g.A + (size_t)cur.pm * tstep; const char* cB = (const char*)g.Bt + (size_t)cur.pn * tstep;
    S.a_ready(cur);
    if constexpr (SP2) {
        PG8_STAGE(PG8_SB(0, 0), cB, voffB); PG8_STAGE(PG8_SB(0, 1), cB + hstep, voffB); PG8_STAGE(PG8_SA(0, 0), cA, voffA); PG8_STAGE(PG8_SA(0, 1), cA + hstep, voffA);
        if (wr == 1) PG8_BAR;
        PG8_WAIT_V(2); PG8_BAR;
        PG8_STAGE(PG8_SB(1, 0), cB + kstep, voffB); PG8_STAGE(PG8_SA(1, 0), cA + kstep, voffA); PG8_STAGE(PG8_SB(1, 1), cB + hstep + kstep, voffB);
        PG8_WAIT_V(6); PG8_BAR;
    } else {
        PG8_STAGE(PG8_SB(0, 0), cB, voffB); PG8_STAGE(PG8_SA(0, 0), cA, voffA); PG8_STAGE(PG8_SB(0, 1), cB + hstep, voffB); PG8_STAGE(PG8_SA(0, 1), cA + hstep, voffA);
        if (wr == 1) PG8_BAR;
        PG8_WAIT_V(4); PG8_BAR;
        PG8_STAGE(PG8_SB(1, 0), cB + kstep, voffB); PG8_STAGE(PG8_SA(1, 0), cA + kstep, voffA); PG8_STAGE(PG8_SB(1, 1), cB + hstep + kstep, voffB);
        PG8_WAIT_V(6); PG8_BAR;
    }
    for (;;) {
        const bool has_next = S.next(ui + 1, nxt);
        const char* nA = has_next ? (const char*)g.A + (size_t)nxt.pm * tstep : cA; const char* nB = has_next ? (const char*)g.Bt + (size_t)nxt.pn * tstep : cB;
        for (int t = 0; t < nt; t += 2) {
            const bool last = (t == nt - 2);
            const char* a1 = cA + (size_t)(t + 1) * kstep;
            const char* a2 = last ? nA : cA + (size_t)(t + 2) * kstep; const char* b2 = last ? nB : cB + (size_t)(t + 2) * kstep;
            const char* a3 = a2 + kstep; const char* b3 = b2 + kstep;
            if (last && has_next) S.a_ready(nxt);
            if constexpr (SP2) {
            PG8_LDB(B0, 0, 0); PG8_LDB(B1, 0, 1); PG8_SCHED; PG8_LDA(At, 0, 0); PG8_STAGE(PG8_SA(1, 1), a1 + hstep, voffA);
            PG8_WAIT_V(8); PG8_WAIT_L(0); PG8_BAR; PG8_MMA(0, 0, At, B0); PG8_MMA(0, 1, At, B1); PG8_BAR; PG8_SCHED;
            PG8_LDA(At, 0, 1); PG8_STAGE(PG8_SB(0, 0), b2, voffB); PG8_STAGE(PG8_SB(0, 1), b2 + hstep, voffB); PG8_STAGE(PG8_SA(0, 0), a2, voffA);
            PG8_WAIT_V(8); PG8_WAIT_L(0); PG8_BAR; PG8_MMA(1, 0, At, B0); PG8_MMA(1, 1, At, B1); PG8_BAR; PG8_SCHED;
            PG8_LDB(B0, 1, 0); PG8_LDB(B1, 1, 1); PG8_SCHED; PG8_LDA(At, 1, 0); PG8_STAGE(PG8_SA(0, 1), a2 + hstep, voffA);
            PG8_WAIT_V(8); PG8_WAIT_L(0); PG8_BAR; PG8_MMA(0, 0, At, B0); PG8_MMA(0, 1, At, B1); PG8_BAR; PG8_SCHED;
            PG8_LDA(At, 1, 1); PG8_STAGE(PG8_SB(1, 0), b3, voffB); PG8_STAGE(PG8_SB(1, 1), b3 + hstep, voffB); PG8_STAGE(PG8_SA(1, 0), a3, voffA);
            PG8_WAIT_V(8); PG8_WAIT_L(0); PG8_BAR; PG8_MMA(1, 0, At, B0); PG8_MMA(1, 1, At, B1); PG8_BAR; PG8_SCHED;
            } else {
            PG8_LDB(B0, 0, 0); PG8_SCHED; PG8_LDA(At, 0, 0); PG8_STAGE(PG8_SA(1, 1), a1 + hstep, voffA);
            PG8_WAIT_L(8); PG8_BAR; PG8_WAIT_L(0); PG8_MMA(0, 0, At, B0); PG8_BAR; PG8_SCHED;
            PG8_LDB(B1, 0, 1); PG8_STAGE(PG8_SB(0, 0), b2, voffB);
            PG8_BAR; PG8_WAIT_L(0); PG8_MMA(0, 1, At, B1); PG8_BAR;
            PG8_LDA(At, 0, 1); PG8_STAGE(PG8_SA(0, 0), a2, voffA);
            PG8_BAR; PG8_WAIT_L(0); PG8_MMA(1, 0, At, B0); PG8_BAR; PG8_SCHED;
            PG8_STAGE(PG8_SB(0, 1), b2 + hstep, voffB);
            PG8_WAIT_V(6); PG8_BAR; PG8_MMA(1, 1, At, B1); PG8_BAR;
            PG8_LDB(B0, 1, 0); PG8_SCHED; PG8_LDA(At, 1, 0); PG8_STAGE(PG8_SA(0, 1), a2 + hstep, voffA);
            PG8_WAIT_L(8); PG8_BAR; PG8_WAIT_L(0); PG8_MMA(0, 0, At, B0); PG8_BAR; PG8_SCHED;
            PG8_LDB(B1, 1, 1); PG8_STAGE(PG8_SB(1, 0), b3, voffB);
            PG8_BAR; PG8_WAIT_L(0); PG8_MMA(0, 1, At, B1); PG8_BAR;
            PG8_LDA(At, 1, 1); PG8_STAGE(PG8_SA(1, 0), a3, voffA);
            PG8_BAR; PG8_WAIT_L(0); PG8_MMA(1, 0, At, B0); PG8_BAR; PG8_SCHED;
            PG8_STAGE(PG8_SB(1, 1), b3 + hstep, voffB);
            PG8_WAIT_V(6); PG8_BAR; PG8_MMA(1, 1, At, B1); PG8_BAR;
            }
        }
        if constexpr (ALIGN_EPI) { if (wr == 0) PG8_BAR; }
        if constexpr (!Epi::AFTER_DRAIN) { E(acc, cur, wr, wc, fr, fq); S.done(cur); }
        if (!has_next) break;
#pragma unroll
        for (int a = 0; a < 2; ++a)
#pragma unroll
            for (int b = 0; b < 2; ++b)
#pragma unroll
                for (int m = 0; m < 4; ++m)
#pragma unroll
                    for (int n = 0; n < 2; ++n) acc[a][b][m][n] = (f32x4){0.f, 0.f, 0.f, 0.f};
        cur = nxt; cA = nA; cB = nB; ++ui;
        if constexpr (ALIGN_EPI) { if (wr == 1) PG8_BAR; }
    }
    PG8_WAIT_V(0);
    if constexpr (!ALIGN_EPI) { if (wr == 0) PG8_BAR; }
    PG8_BAR;
    if constexpr (Epi::AFTER_DRAIN) { E.fused(acc, cur, wr, wc, fr, fq, lds, wid, lane); S.done(cur); }
#undef PG8_SA
#undef PG8_SB
#undef PG8_STAGE
#undef PG8_LDA
#undef PG8_LDB
#undef PG8_MMA
#undef PG8_WAIT_V
#undef PG8_WAIT_L
#undef PG8_BAR
#undef PG8_SCHED
}
}
namespace pg8 {
constexpr float RMS_EPS = 1e-6f;
__device__ __forceinline__ unsigned cvt_pk_bf16(float lo, float hi) { unsigned r; asm volatile("v_cvt_pk_bf16_f32 %0, %1, %2" : "=v"(r) : "v"(lo), "v"(hi)); return r; }
__device__ __forceinline__ u32x4 pack8(const f32x4 a, const f32x4 b) { u32x4 w; w.x = cvt_pk_bf16(a[0], a[1]); w.y = cvt_pk_bf16(a[2], a[3]); w.z = cvt_pk_bf16(b[0], b[1]); w.w = cvt_pk_bf16(b[2], b[3]); return w; }
__device__ __forceinline__ float dot4(const f32x4 a) { return (a[0] * a[0] + a[1] * a[1]) + (a[2] * a[2] + a[3] * a[3]); }
__device__ __forceinline__ float fq_sum(float s) { s += __shfl_xor(s, 16); s += __shfl_xor(s, 32); return s; }
#define PG8_EPI_BAR() do { asm volatile("s_waitcnt lgkmcnt(0)" ::: "memory"); __builtin_amdgcn_s_barrier(); asm volatile("" ::: "memory"); } while (0)
typedef float f32x4a __attribute__((ext_vector_type(4)));

struct EpiInProj {
    static constexpr bool PERM = true, AFTER_DRAIN = false;
    bf16_t *QA, *KA, *VA, *QB, *KB, *VB, *CQL, *CKVL; float* CKR; float *SSQ_Q, *SSQ_KV, *SSQ_KR;
    const float *gaq, *gak, *gbq, *gbk;
    const float *tcC, *tsC, *tcB, *tsB;
    PG8_LAS float* P;
    __device__ __forceinline__ void plain(const f32x4 (&acc)[2][2][4][2], int row0, int wc, int fq, bf16_t* dst, int ld) const {
#pragma unroll
        for (int ai = 0; ai < 2; ++ai)
#pragma unroll
            for (int m = 0; m < 4; ++m) { bf16_t* rowp = dst + (size_t)(row0 + ai * HALF + m * 16) * ld + wc * 32 + 8 * fq;
#pragma unroll
                for (int bj = 0; bj < 2; ++bj) *(u32x4*)(rowp + bj * HALF) = pack8(acc[ai][bj][m][0], acc[ai][bj][m][1]); }
    }
    __device__ __forceinline__ void row_ssq(const f32x4 (&acc)[2][2][4][2], int row0, int fq, float* ssq, bool both) const {
#pragma unroll
        for (int ai = 0; ai < 2; ++ai)
#pragma unroll
            for (int m = 0; m < 4; ++m) { float s = dot4(acc[ai][0][m][0]) + dot4(acc[ai][0][m][1]); if (both) s += dot4(acc[ai][1][m][0]) + dot4(acc[ai][1][m][1]);
                s = fq_sum(s); if (fq == 0) __hip_atomic_fetch_add(ssq + row0 + ai * HALF + m * 16, s, __ATOMIC_RELAXED, __HIP_MEMORY_SCOPE_AGENT); }
    }
    __device__ __forceinline__ void partials(const f32x4 (&acc)[2][2][4][2], int wr, int wc, int fr, int fq) const {
#pragma unroll
        for (int ai = 0; ai < 2; ++ai)
#pragma unroll
            for (int m = 0; m < 4; ++m)
#pragma unroll
                for (int bj = 0; bj < 2; ++bj) { float s = dot4(acc[ai][bj][m][0]) + dot4(acc[ai][bj][m][1]); s = fq_sum(s);
                    if (fq == 0) P[(ai * HALF + wr * 64 + m * 16 + fr) * 8 + bj * 4 + wc] = s; }
    }
    __device__ __forceinline__ void operator()(const f32x4 (&acc)[2][2][4][2], const Unit& u, int wr, int wc, int fr_, int fq_) const {
        int fr = fr_, fq = fq_; asm volatile("" : "+v"(fr), "+v"(fq));
        const int pn = u.pn, row0 = u.pm * BM + wr * 64 + fr;
        if (pn < 8) {
            bf16_t* dst = pn < 6 ? QA + pn * 256 : KA + (pn - 6) * 256; const int ld = pn < 6 ? 1536 : 512; const float* gain = pn < 6 ? gaq : gak;
            partials(acc, wr, wc, fr, fq); PG8_EPI_BAR();
            const int hh = wc >> 1, i0 = (wc & 1) * 16 + fq * 4;
            const f32x4 g1 = *(const f32x4*)(gain + hh * 64 + i0), g2 = *(const f32x4*)(gain + hh * 64 + 32 + i0);
#pragma unroll
            for (int ai = 0; ai < 2; ++ai)
#pragma unroll
                for (int m = 0; m < 4; ++m) { const int rl = ai * HALF + wr * 64 + m * 16 + fr, t = u.pm * BM + rl;
                    const f32x4 pa = *(const PG8_LAS f32x4*)(P + rl * 8), pb = *(const PG8_LAS f32x4*)(P + rl * 8 + 4);
                    const float r0 = rsqrtf(((pa[0] + pa[1]) + (pa[2] + pa[3])) * (1.0f / 128.0f) + RMS_EPS), r1 = rsqrtf(((pb[0] + pb[1]) + (pb[2] + pb[3])) * (1.0f / 128.0f) + RMS_EPS);
                    const int pos = hh ? (t & 63) : (t >> 6);
                    const f32x4 c = *(const f32x4*)(tcC + pos * 32 + i0), s = *(const f32x4*)(tsC + pos * 32 + i0);
                    bf16_t* rowp = dst + (size_t)t * ld + wc * 32 + 8 * fq;
#pragma unroll
                    for (int bj = 0; bj < 2; ++bj) { const float r = bj ? r1 : r0; const f32x4 a = acc[ai][bj][m][0] * r * g1, b = acc[ai][bj][m][1] * r * g2;
                        *(u32x4*)(rowp + bj * HALF) = pack8(a * c - b * s, b * c + a * s); }
                    asm volatile("" ::: "memory"); }
        } else if (pn < 10) { plain(acc, row0, wc, fq, VA + (pn - 8) * 256, 512);
        } else if (pn < 18) {
            bf16_t* dst = pn < 14 ? QB + (pn - 10) * 256 : KB + (pn - 14) * 256; const float* gain = pn < 14 ? gbq : gbk;
            partials(acc, wr, wc, fr, fq); PG8_EPI_BAR();
            const bool rope = ((wc & 1) == 0) && (fq < 2);
            const int l1 = rope ? fq * 4 : (wc & 1) * 32 + fq * 8, l2 = rope ? 8 + fq * 4 : (wc & 1) * 32 + fq * 8 + 4;
            const f32x4 g1 = *(const f32x4*)(gain + l1), g2 = *(const f32x4*)(gain + l2);
            const int sub = (wc >> 1) * 2;
#pragma unroll
            for (int ai = 0; ai < 2; ++ai)
#pragma unroll
                for (int m = 0; m < 4; ++m) { const int rl = ai * HALF + wr * 64 + m * 16 + fr, t = u.pm * BM + rl;
                    const float r0 = rsqrtf((P[rl * 8 + sub] + P[rl * 8 + sub + 1]) * (1.0f / 64.0f) + RMS_EPS), r1 = rsqrtf((P[rl * 8 + 4 + sub] + P[rl * 8 + 4 + sub + 1]) * (1.0f / 64.0f) + RMS_EPS);
                    f32x4 c = (f32x4){1.f, 1.f, 1.f, 1.f}, s = (f32x4){0.f, 0.f, 0.f, 0.f};
                    if (rope) { c = *(const f32x4*)(tcB + t * 8 + fq * 4); s = *(const f32x4*)(tsB + t * 8 + fq * 4); }
                    bf16_t* rowp = dst + (size_t)t * 1024 + wc * 32 + 8 * fq;
#pragma unroll
                    for (int bj = 0; bj < 2; ++bj) { const float r = bj ? r1 : r0; const f32x4 a = acc[ai][bj][m][0] * r * g1, b = acc[ai][bj][m][1] * r * g2;
                        *(u32x4*)(rowp + bj * HALF) = pack8(a * c - b * s, b * c + a * s); }
                    asm volatile("" ::: "memory"); }
        } else if (pn < 22) { plain(acc, row0, wc, fq, VB + (pn - 18) * 256, 1024);
        } else if (pn < 26) { plain(acc, row0, wc, fq, CQL + (pn - 22) * 256, 1024); row_ssq(acc, row0, fq, SSQ_Q, true);
        } else if (pn < 28) { plain(acc, row0, wc, fq, CKVL + (pn - 26) * 256, 512); row_ssq(acc, row0, fq, SSQ_KV, true);
        } else {
            if (wc < 2) {
#pragma unroll
                for (int ai = 0; ai < 2; ++ai)
#pragma unroll
                    for (int m = 0; m < 4; ++m) { float* rowp = CKR + (size_t)(row0 + ai * HALF + m * 16) * 64 + wc * 32 + 8 * fq;
                        *(f32x4*)rowp = acc[ai][0][m][0]; *(f32x4*)(rowp + 4) = acc[ai][0][m][1]; }
                row_ssq(acc, row0, fq, SSQ_KR, false);
            }
        }
    }
};

struct EpiQUp {
    static constexpr bool PERM = true, AFTER_DRAIN = false;
    bf16_t* QC; const float* SSQ_Q; const float* gq; const float *tcC, *tsC; PG8_LAS float* P;
    __device__ __forceinline__ void operator()(const f32x4 (&acc)[2][2][4][2], const Unit& u, int wr, int wc, int fr_, int fq_) const {
        int fr = fr_, fq = fq_; asm volatile("" : "+v"(fr), "+v"(fq));
#pragma unroll
        for (int ai = 0; ai < 2; ++ai)
#pragma unroll
            for (int m = 0; m < 4; ++m)
#pragma unroll
                for (int bj = 0; bj < 2; ++bj) { float s = dot4(acc[ai][bj][m][0]) + dot4(acc[ai][bj][m][1]); s = fq_sum(s);
                    if (fq == 0) P[(ai * HALF + wr * 64 + m * 16 + fr) * 8 + bj * 4 + wc] = s; }
        PG8_EPI_BAR();
        const int h = u.pn, cn = wc * 32 + 8 * fq, i0 = (wc & 1) * 16 + fq * 4;
        const f32x4 gn1 = *(const f32x4*)(gq + cn), gn2 = *(const f32x4*)(gq + cn + 4);
        const f32x4 gr1 = *(const f32x4*)(gq + 128 + i0), gr2 = *(const f32x4*)(gq + 160 + i0);
#pragma unroll
        for (int ai = 0; ai < 2; ++ai)
#pragma unroll
            for (int m = 0; m < 4; ++m) { const int rl = ai * HALF + wr * 64 + m * 16 + fr, t = u.pm * BM + rl;
                const f32x4 pa = *(const PG8_LAS f32x4*)(P + rl * 8); const float pb0 = P[rl * 8 + 4], pb1 = P[rl * 8 + 5];
                const float rs = rsqrtf(SSQ_Q[t] * (1.0f / 1024.0f) + RMS_EPS);
                const float tot = (((pa[0] + pa[1]) + (pa[2] + pa[3])) + (pb0 + pb1)) * rs * rs;
                const float f = rs * rsqrtf(tot * (1.0f / 192.0f) + RMS_EPS);
                bf16_t* rowp = QC + (size_t)t * 2304 + h * 192;
                *(u32x4*)(rowp + cn) = pack8(acc[ai][0][m][0] * f * gn1, acc[ai][0][m][1] * f * gn2);
                if (wc < 2) { const f32x4 c = *(const f32x4*)(tcC + t * 32 + i0), s = *(const f32x4*)(tsC + t * 32 + i0);
                    const f32x4 a = acc[ai][1][m][0] * f * gr1, b = acc[ai][1][m][1] * f * gr2;
                    *(u32x4*)(rowp + 128 + cn) = pack8(a * c - b * s, b * c + a * s); }
                asm volatile("" ::: "memory"); }
    }
};

struct EpiKVUp {
    static constexpr bool PERM = true, AFTER_DRAIN = false;
    bf16_t *KC, *VC; const float *SSQ_KV, *SSQ_KR, *CKR; const float* gk; const float *tcC, *tsC; PG8_LAS float* P;
    __device__ __forceinline__ void operator()(const f32x4 (&acc)[2][2][4][2], const Unit& u, int wr, int wc, int fr_, int fq_) const {
        int fr = fr_, fq = fq_; asm volatile("" : "+v"(fr), "+v"(fq));
#pragma unroll
        for (int ai = 0; ai < 2; ++ai)
#pragma unroll
            for (int m = 0; m < 4; ++m) { float s = dot4(acc[ai][0][m][0]) + dot4(acc[ai][0][m][1]); s = fq_sum(s);
                if (fq == 0) P[(ai * HALF + wr * 64 + m * 16 + fr) * 8 + wc] = s; }
        PG8_EPI_BAR();
        const int h = u.pn, cn = wc * 32 + 8 * fq;
        const f32x4 gn1 = *(const f32x4*)(gk + cn), gn2 = *(const f32x4*)(gk + cn + 4);
#pragma unroll
        for (int ai = 0; ai < 2; ++ai)
#pragma unroll
            for (int m = 0; m < 4; ++m) { const int rl = ai * HALF + wr * 64 + m * 16 + fr, t = u.pm * BM + rl;
                const f32x4 pa = *(const PG8_LAS f32x4*)(P + rl * 8);
                const float rs = rsqrtf(SSQ_KV[t] * (1.0f / 512.0f) + RMS_EPS);
                const float tot = ((pa[0] + pa[1]) + (pa[2] + pa[3])) * rs * rs + SSQ_KR[t];
                const float rk = rsqrtf(tot * (1.0f / 192.0f) + RMS_EPS), f = rs * rk;
                *(u32x4*)(KC + (size_t)t * 2304 + h * 192 + cn) = pack8(acc[ai][0][m][0] * f * gn1, acc[ai][0][m][1] * f * gn2);
                *(u32x4*)(VC + (size_t)t * 1536 + h * 128 + cn) = pack8(acc[ai][1][m][0] * rs, acc[ai][1][m][1] * rs);
                if (wc == 0 && fq == 0) P[2048 + rl] = rk;
                asm volatile("" ::: "memory"); }
        PG8_EPI_BAR();
        int tid = threadIdx.x; asm volatile("" : "+v"(tid));
#pragma unroll
        for (int k = 0; k < 4; ++k) { const int id = tid + 512 * k, rl = id >> 3, c8 = id & 7, i0 = (c8 >> 2) * 16 + (c8 & 3) * 4, t = u.pm * BM + rl;
            const float rk = P[2048 + rl];
            const f32x4 x1 = *(const f32x4*)(CKR + (size_t)t * 64 + i0), x2 = *(const f32x4*)(CKR + (size_t)t * 64 + 32 + i0);
            const f32x4 g1 = *(const f32x4*)(gk + 128 + i0), g2 = *(const f32x4*)(gk + 160 + i0);
            const f32x4 c = *(const f32x4*)(tcC + t * 32 + i0), s = *(const f32x4*)(tsC + t * 32 + i0);
            const f32x4 a = x1 * rk * g1, b = x2 * rk * g2;
            *(u32x4*)(KC + (size_t)t * 2304 + h * 192 + 128 + 8 * c8) = pack8(a * c - b * s, b * c + a * s);
            asm volatile("" ::: "memory"); }
    }
};

struct EpiResid {
    static constexpr bool PERM = false, AFTER_DRAIN = false;
    const float* base; float* out; int ldc;
    __device__ __forceinline__ void operator()(const f32x4 (&acc)[2][2][4][2], const Unit& u, int wr, int wc, int fr_, int fq_) const {
        int fr = fr_, fq = fq_; asm volatile("" : "+v"(fr), "+v"(fq));
        const int col0 = u.pn * BM + wc * 32 + 4 * fq;
#pragma unroll
        for (int ai = 0; ai < 2; ++ai)
#pragma unroll
            for (int m = 0; m < 4; ++m) { const size_t off = (size_t)(u.pm * BM + ai * HALF + wr * 64 + m * 16 + fr) * ldc + col0;
#pragma unroll
                for (int bj = 0; bj < 2; ++bj)
#pragma unroll
                    for (int n = 0; n < 2; ++n) { const f32x4 bs = *(const f32x4*)(base + off + bj * HALF + n * 16); *(f32x4*)(out + off + bj * HALF + n * 16) = bs + acc[ai][bj][m][n]; } }
    }
};

struct EpiGateUp {
    static constexpr bool PERM = true, AFTER_DRAIN = false;
    bf16_t* ACT; int ldc;
    __device__ __forceinline__ void operator()(const f32x4 (&acc)[2][2][4][2], const Unit& u, int wr, int wc, int fr_, int fq_) const {
        int fr = fr_, fq = fq_; asm volatile("" : "+v"(fr), "+v"(fq));
        const int col0 = u.pn * HALF + wc * 32 + 8 * fq;
#pragma unroll
        for (int ai = 0; ai < 2; ++ai)
#pragma unroll
            for (int m = 0; m < 4; ++m) { f32x4 o[2];
#pragma unroll
                for (int n = 0; n < 2; ++n) { const f32x4 g = acc[ai][0][m][n], up = acc[ai][1][m][n];
#pragma unroll
                    for (int j = 0; j < 4; ++j) { const float e = __builtin_amdgcn_exp2f(g[j] * -1.4426950408889634f); o[n][j] = g[j] * __builtin_amdgcn_rcpf(1.0f + e) * up[j]; } }
                *(u32x4*)(ACT + (size_t)(u.pm * BM + ai * HALF + wr * 64 + m * 16 + fr) * ldc + col0) = pack8(o[0], o[1]); }
    }
};
}
namespace att {
typedef unsigned short bf16_t;
using bf16x8 = __attribute__((ext_vector_type(8))) short;
using s16x4  = __attribute__((ext_vector_type(4))) short;
using f32x16 = __attribute__((ext_vector_type(16))) float;
using u32x4  = __attribute__((ext_vector_type(4))) unsigned;
constexpr int NW = 8, QBLK = 32, KVBLK = 64;
constexpr int SHM_V = KVBLK * 128 * 2;
template <int NKS> struct KCfg { static constexpr int DQK = NKS * 16, KROW = DQK * 2 + 16, SHM_K = KVBLK * KROW, CPR = DQK / 8, NCH = DQK / 64; };
template <int NKS, int QL> constexpr int lds_bytes() { return 2 * SHM_V + 2 * KCfg<NKS>::SHM_K + NW * 64 * 4 + (QL ? NW * 32 * (QL * 32 + 16) : 0); }
#define SBAR() __builtin_amdgcn_sched_barrier(0)
__device__ __forceinline__ int crow(int r, int hi) { return (r & 3) + 8 * (r >> 2) + 4 * hi; }
__device__ __forceinline__ unsigned cvtpk(float lo, float hi) { unsigned r; asm volatile("v_cvt_pk_bf16_f32 %0, %1, %2" : "=v"(r) : "v"(lo), "v"(hi)); return r; }
constexpr float THR = 8.f;

__device__ __forceinline__ void partialSM(f32x16& p0, f32x16& p1, float& m_reg, float& mn, float& alpha, const float C, const float THRR) {
  float pmax = p0[0];
#pragma unroll
  for (int r = 1; r < 16; ++r) pmax = fmaxf(pmax, p0[r]);
#pragma unroll
  for (int r = 0; r < 16; ++r) pmax = fmaxf(pmax, p1[r]);
  { auto rr = __builtin_amdgcn_permlane32_swap(__float_as_uint(pmax), __float_as_uint(pmax), false, false);
    pmax = fmaxf(__uint_as_float(rr[0]), __uint_as_float(rr[1])); }
  if (__builtin_expect(__all(pmax - m_reg <= THRR), 1)) { mn = m_reg; alpha = 1.f; }
  else { mn = fmaxf(m_reg, pmax); alpha = __builtin_amdgcn_exp2f((m_reg - mn) * C); m_reg = mn; }
  const float mnC = -mn * C;
#pragma unroll
  for (int r = 0; r < 16; ++r) p0[r] = fmaf(p0[r], C, mnC);
#pragma unroll
  for (int r = 0; r < 16; ++r) p1[r] = fmaf(p1[r], C, mnC);
#pragma unroll
  for (int r = 0; r < 16; ++r) p0[r] = __builtin_amdgcn_exp2f(p0[r]);
}
__device__ __forceinline__ void finishSM(f32x16& p0, f32x16& p1, float alpha, float& l_reg, bf16x8& pa0, bf16x8& pa1, bf16x8& pa2, bf16x8& pa3) {
#pragma unroll
  for (int r = 0; r < 16; ++r) p1[r] = __builtin_amdgcn_exp2f(p1[r]);
  float ps = 0;
#pragma unroll
  for (int r = 0; r < 16; ++r) ps += p0[r];
#pragma unroll
  for (int r = 0; r < 16; ++r) ps += p1[r];
  { auto rr = __builtin_amdgcn_permlane32_swap(__float_as_uint(ps), __float_as_uint(ps), false, false);
    ps = __uint_as_float(rr[0]) + __uint_as_float(rr[1]); }
  l_reg = l_reg * alpha + ps;
#define PK4(P, BASE, OUT) do { unsigned a0 = cvtpk(P[BASE + 0], P[BASE + 1]), a1 = cvtpk(P[BASE + 2], P[BASE + 3]);   \
    unsigned b0 = cvtpk(P[BASE + 4], P[BASE + 5]), b1 = cvtpk(P[BASE + 6], P[BASE + 7]);                              \
    auto r0 = __builtin_amdgcn_permlane32_swap(a0, b0, false, false); auto r1 = __builtin_amdgcn_permlane32_swap(a1, b1, false, false); \
    u32x4 w = {r0[0], r1[0], r0[1], r1[1]}; OUT = *reinterpret_cast<bf16x8*>(&w); } while (0)
  PK4(p0, 0, pa0); PK4(p0, 8, pa1); PK4(p1, 0, pa2); PK4(p1, 8, pa3);
#undef PK4
}
template <int NKS, int QL> __device__ __forceinline__ void qkt(f32x16& p0, f32x16& p1, const char* Ks, const bf16x8* qr, const char* ql, int r32, int hi) {
  constexpr int KROW = KCfg<NKS>::KROW;
  p0 = f32x16{}; p1 = f32x16{};
#pragma unroll
  for (int d0 = 0; d0 < NKS; ++d0) { const int cb = (d0 * 16 + hi * 8) * 2;
    const bf16x8 b0 = *reinterpret_cast<const bf16x8*>(Ks + r32 * KROW + cb);
    const bf16x8 b1 = *reinterpret_cast<const bf16x8*>(Ks + (32 + r32) * KROW + cb);
    bf16x8 q; if constexpr (QL > 0) { if (d0 >= NKS - QL) q = *reinterpret_cast<const bf16x8*>(ql + (d0 - (NKS - QL)) * 32); else q = qr[d0]; } else q = qr[d0];
    p0 = __builtin_amdgcn_mfma_f32_32x32x16_bf16(b0, q, p0, 0, 0, 0);
    p1 = __builtin_amdgcn_mfma_f32_32x32x16_bf16(b1, q, p1, 0, 0, 0); }
}
__device__ __forceinline__ int v_st(int k, int c) { const int kk = (k & ~0xC) | ((k & 4) << 1) | ((k & 8) >> 1); return ((kk >> 3) * 4 + (c >> 5)) * 512 + ((kk & 7) * 32 + (c & 31)) * 2; }
__device__ __forceinline__ int v_rd_base(int lane) { return ((lane & 3) << 3) | (((lane >> 2) & 3) << 6) | (((lane >> 4) & 1) << 5) | (((lane >> 5) & 1) << 8); }
constexpr int v_rd_off(int d0, int ks, int half) { return d0 * 512 + ks * 4096 + half * 2048; }
template <int OFF> __device__ __forceinline__ s16x4 tr_read(int vb) {
  s16x4 r; asm volatile("ds_read_b64_tr_b16 %0, %1 offset:%2" : "=&v"(r) : "v"(vb), "i"(OFF) : "memory"); return r;
}
template <int D0> __device__ __forceinline__ void pv_one(f32x16& od, int vb, bf16x8 pa0, bf16x8 pa1, bf16x8 pa2, bf16x8 pa3) {
  const s16x4 l0 = tr_read<v_rd_off(D0, 0, 0)>(vb), h0 = tr_read<v_rd_off(D0, 0, 1)>(vb), l1 = tr_read<v_rd_off(D0, 1, 0)>(vb), h1 = tr_read<v_rd_off(D0, 1, 1)>(vb);
  const s16x4 l2 = tr_read<v_rd_off(D0, 2, 0)>(vb), h2 = tr_read<v_rd_off(D0, 2, 1)>(vb), l3 = tr_read<v_rd_off(D0, 3, 0)>(vb), h3 = tr_read<v_rd_off(D0, 3, 1)>(vb);
  asm volatile("s_waitcnt lgkmcnt(0)" ::: "memory"); SBAR();
#define PK(L, H) (bf16x8){L[0], L[1], L[2], L[3], H[0], H[1], H[2], H[3]}
  od = __builtin_amdgcn_mfma_f32_32x32x16_bf16(pa0, PK(l0, h0), od, 0, 0, 0);
  od = __builtin_amdgcn_mfma_f32_32x32x16_bf16(pa1, PK(l1, h1), od, 0, 0, 0);
  od = __builtin_amdgcn_mfma_f32_32x32x16_bf16(pa2, PK(l2, h2), od, 0, 0, 0);
  od = __builtin_amdgcn_mfma_f32_32x32x16_bf16(pa3, PK(l3, h3), od, 0, 0, 0);
#undef PK
}
__device__ __forceinline__ void pv_d0(f32x16* o, int vb, bf16x8 pa0, bf16x8 pa1, bf16x8 pa2, bf16x8 pa3) {
  pv_one<0>(o[0], vb, pa0, pa1, pa2, pa3); pv_one<1>(o[1], vb, pa0, pa1, pa2, pa3); pv_one<2>(o[2], vb, pa0, pa1, pa2, pa3); pv_one<3>(o[3], vb, pa0, pa1, pa2, pa3);
}

template <int NKS, int SD, int QL, bool DBL, int ldq, int ldk, int ldv>
__device__ __forceinline__ void attn_pass(const bf16_t* __restrict__ Qb, const bf16_t* __restrict__ Kh, const bf16_t* __restrict__ Vh,
                                          const int seq, char* lds, const float C, const float THRR, f32x16 (&o)[4]) {
  using KC = KCfg<NKS>; constexpr int KROW = KC::KROW, SHM_K = KC::SHM_K, CPR = KC::CPR, NCH = KC::NCH;
  int tid_ = threadIdx.x; asm volatile("" : "+v"(tid_));
  const int tid = tid_, wid = tid >> 6, lane = tid & 63, r32 = lane & 31, hi = lane >> 5;
  char* V_lds = lds; char* K_lds = lds + 2 * SHM_V;
  float* ws = (float*)(lds + 2 * SHM_V + 2 * SHM_K) + wid * 64; float* li_l = ws; float* al_l = ws + 32;
  float m_reg = -1e30f, l_reg = 0; bf16x8 qr[NKS - QL];
  constexpr int QROW = QL * 32 + 16; char* ql = lds + 2 * SHM_V + 2 * SHM_K + NW * 64 * 4 + wid * (32 * QROW) + r32 * QROW + hi * 16;
#pragma unroll
  for (int d = 0; d < 4; ++d) o[d] = f32x16{};
  const bf16_t* Qw = Qb + (long)(wid * QBLK + r32) * ldq + hi * 8;
#pragma unroll
  for (int d0 = 0; d0 < NKS; ++d0) { const bf16x8 qv = *reinterpret_cast<const bf16x8*>(Qw + d0 * 16); if (d0 < NKS - QL) qr[d0 < NKS - QL ? d0 : 0] = qv; else *reinterpret_cast<bf16x8*>(ql + (d0 - (NKS - QL)) * 32) = qv; }
  const int sr = tid >> 4, sc = (tid & 15) * 8, vst0 = v_st(sr, sc), vst1 = v_st(32 + sr, sc);
  int kgo[NCH], klo[NCH];
#pragma unroll
  for (int i = 0; i < NCH; ++i) { const int id = tid + 512 * i, row = id / CPR, ch = id % CPR; kgo[i] = row * ldk + ch * 8; klo[i] = row * KROW + ch * 16; }
  const int vb0 = (int)(uintptr_t)V_lds + v_rd_base(lane);
  struct { bf16x8 vs0, vs1, ks[NCH]; } sr_[SD];
#define SLOAD(i, k0) do { sr_[i].vs0 = *reinterpret_cast<const bf16x8*>(&Vh[(long)((k0) + sr) * ldv + sc]); sr_[i].vs1 = *reinterpret_cast<const bf16x8*>(&Vh[(long)((k0) + 32 + sr) * ldv + sc]); \
    _Pragma("unroll") for (int c_ = 0; c_ < NCH; ++c_) sr_[i].ks[c_] = *reinterpret_cast<const bf16x8*>(&Kh[(long)(k0) * ldk + kgo[c_]]); } while (0)
#define SWRITE(b, i) do { *(bf16x8*)(V_lds + (b) * SHM_V + vst0) = sr_[i].vs0; *(bf16x8*)(V_lds + (b) * SHM_V + vst1) = sr_[i].vs1; \
    _Pragma("unroll") for (int c_ = 0; c_ < NCH; ++c_) *(bf16x8*)(K_lds + (b) * SHM_K + klo[c_]) = sr_[i].ks[c_]; } while (0)
#define SWAIT() do { if constexpr (SD == 2) { if constexpr (NCH == 1) asm volatile("s_waitcnt vmcnt(3)" ::: "memory"); else if constexpr (NCH == 2) asm volatile("s_waitcnt vmcnt(4)" ::: "memory"); else asm volatile("s_waitcnt vmcnt(5)" ::: "memory"); } \
    else asm volatile("s_waitcnt vmcnt(0)" ::: "memory"); } while (0)
#define RESC(a) do { if (__any((a) < 1.f)) { if (hi == 0) al_l[r32] = (a); asm volatile("s_waitcnt lgkmcnt(0)" ::: "memory"); \
    _Pragma("unroll") for (int d = 0; d < 4; ++d) _Pragma("unroll") for (int r = 0; r < 16; ++r) o[d][r] *= al_l[crow(r, hi)]; } } while (0)
  const int NT = seq / KVBLK; constexpr int SE = 0, SO = SD - 1;
  if constexpr (!DBL) {
    static_assert(SD == 1, "single-state loop stages one tile ahead");
    f32x16 p0, p1; float mn, al; bf16x8 pa0, pa1, pa2, pa3;
    SLOAD(0, 0); asm volatile("s_waitcnt vmcnt(0)" ::: "memory"); SWRITE(0, 0); __syncthreads();
    for (int j = 0; j < NT; j += 2) {
      SLOAD(0, (j + 1) * KVBLK); SBAR();
      qkt<NKS, QL>(p0, p1, K_lds, qr, ql, r32, hi); partialSM(p0, p1, m_reg, mn, al, C, THRR); RESC(al);
      finishSM(p0, p1, al, l_reg, pa0, pa1, pa2, pa3); SBAR();
      pv_d0(o, vb0, pa0, pa1, pa2, pa3);
      SWAIT(); SWRITE(1, 0); __syncthreads();
      if (j + 2 < NT) SLOAD(0, (j + 2) * KVBLK); SBAR();
      qkt<NKS, QL>(p0, p1, K_lds + SHM_K, qr, ql, r32, hi); partialSM(p0, p1, m_reg, mn, al, C, THRR); RESC(al);
      finishSM(p0, p1, al, l_reg, pa0, pa1, pa2, pa3); SBAR();
      pv_d0(o, vb0 + SHM_V, pa0, pa1, pa2, pa3);
      if (j + 2 < NT) { SWAIT(); SWRITE(0, 0); } __syncthreads();
    }
  } else {
  f32x16 pA0, pA1, pB0, pB1; float mnA, mnB, alA, alB; bf16x8 pa0, pa1, pa2, pa3;
  SLOAD(SE, 0); asm volatile("s_waitcnt vmcnt(0)" ::: "memory"); SWRITE(0, SE); __syncthreads();
  qkt<NKS, QL>(pA0, pA1, K_lds, qr, ql, r32, hi); partialSM(pA0, pA1, m_reg, mnA, alA, C, THRR);
  SLOAD(SO, KVBLK); if constexpr (SD == 2) { if (2 < NT) SLOAD(SE, 2 * KVBLK); }
  SWAIT(); SWRITE(1, SO); __syncthreads();
  for (int j = 1; j + 1 < NT; j += 2) {
    SBAR(); qkt<NKS, QL>(pB0, pB1, K_lds + SHM_K, qr, ql, r32, hi);
    finishSM(pA0, pA1, alA, l_reg, pa0, pa1, pa2, pa3); SBAR();
    SLOAD(SO, (j + SD) * KVBLK); SBAR();
    pv_d0(o, vb0, pa0, pa1, pa2, pa3); partialSM(pB0, pB1, m_reg, mnB, alB, C, THRR);
    __syncthreads(); SWAIT(); SWRITE(0, SE);
    RESC(alB); __syncthreads();
    SBAR(); qkt<NKS, QL>(pA0, pA1, K_lds, qr, ql, r32, hi);
    finishSM(pB0, pB1, alB, l_reg, pa0, pa1, pa2, pa3); SBAR();
    if (SD == 1 || j + 3 < NT) SLOAD(SE, (j + 1 + SD) * KVBLK); SBAR();
    pv_d0(o, vb0 + SHM_V, pa0, pa1, pa2, pa3); partialSM(pA0, pA1, m_reg, mnA, alA, C, THRR);
    __syncthreads(); SWAIT(); SWRITE(1, SO);
    RESC(alA); __syncthreads();
  }
  SBAR(); qkt<NKS, QL>(pB0, pB1, K_lds + SHM_K, qr, ql, r32, hi);
  finishSM(pA0, pA1, alA, l_reg, pa0, pa1, pa2, pa3); SBAR();
  pv_d0(o, vb0, pa0, pa1, pa2, pa3); partialSM(pB0, pB1, m_reg, mnB, alB, C, THRR);
  __syncthreads(); RESC(alB);
  finishSM(pB0, pB1, alB, l_reg, pa0, pa1, pa2, pa3); SBAR();
  pv_d0(o, vb0 + SHM_V, pa0, pa1, pa2, pa3);
  }
  if (hi == 0) li_l[r32] = l_reg; asm volatile("s_waitcnt lgkmcnt(0)" ::: "memory");
#pragma unroll
  for (int r = 0; r < 16; ++r) { const float rl = __builtin_amdgcn_rcpf(li_l[crow(r, hi)]);
#pragma unroll
    for (int d = 0; d < 4; ++d) o[d][r] *= rl; }
  __syncthreads();
#undef SLOAD
#undef SWRITE
#undef SWAIT
#undef RESC
}
#undef SBAR
}
#define GAS __attribute__((address_space(1)))
#define LAS __attribute__((address_space(3)))
typedef unsigned short bf16;
typedef unsigned v4u __attribute__((ext_vector_type(4)));
typedef float f32x4 __attribute__((ext_vector_type(4)));
typedef short bf16x8 __attribute__((ext_vector_type(8)));
typedef GAS unsigned gu32;
typedef GAS unsigned long long gu64;
#define RLX_AGENT __ATOMIC_RELAXED, __HIP_MEMORY_SCOPE_AGENT
#define LDS_WAIT() asm volatile("s_waitcnt lgkmcnt(0)" ::: "memory")
#define VM_WAIT() asm volatile("s_waitcnt vmcnt(0)" ::: "memory")
__device__ __forceinline__ unsigned long long rt() { return __builtin_amdgcn_s_memrealtime(); }
__device__ __forceinline__ unsigned f2bf(float f) { unsigned u = __builtin_bit_cast(unsigned, f); return (u + 0x7fffu + ((u >> 16) & 1u)) >> 16; }
__device__ __forceinline__ unsigned pk2(float lo, float hi) { return f2bf(lo) | (f2bf(hi) << 16); }

#define XB_TMO      128
#define XB_XCNT(j)  (256  + 64 * (j))
#define XB_XSUB(j)  (1280 + 64 * (j))
#define XB_XGEN(j)  (2304 + 64 * (j))
#define XB_TOP      3328
#define XB_TOPGEN   3392
#define XCD_BAR_WORDS 3456
#define XB_SPIN_CAP (1u << 18)

__device__ __forceinline__ unsigned xb_ld(unsigned* p)              { return __hip_atomic_load(p, __ATOMIC_RELAXED, __HIP_MEMORY_SCOPE_AGENT); }
__device__ __forceinline__ unsigned xb_add(unsigned* p, unsigned v) { return __hip_atomic_fetch_add(p, v, __ATOMIC_RELAXED, __HIP_MEMORY_SCOPE_AGENT); }
__device__ __forceinline__ unsigned xb_xcc_id() { return (unsigned)__builtin_amdgcn_s_getreg((3 << 11) | 20) & 0xFu; }
#define XB_SPIN(cond, bar) do { unsigned _sp = 0; while (cond) { __builtin_amdgcn_s_sleep(1); \
    if ((++_sp & 255u) == 0u) { if (xb_ld(&(bar)[XB_TMO])) break; if (_sp > XB_SPIN_CAP) { atomicAdd(&(bar)[XB_TMO], 1u); break; } } } } while (0)

struct XcdBarrier {
    unsigned* bar; unsigned x;
    volatile LAS unsigned* st;
};

__device__ __forceinline__ XcdBarrier xcd_barrier_post(unsigned* bar, volatile LAS unsigned* st) {
    XcdBarrier b; b.bar = bar; b.x = xb_xcc_id(); b.st = st;
    if (threadIdx.x == 0) (void)xb_add(&bar[XB_XCNT(b.x)], 1u);
    return b;
}
__device__ __forceinline__ void xcd_barrier_complete(unsigned* bar, unsigned x, unsigned& nloc, unsigned& nx) {
    const unsigned G = gridDim.x * gridDim.y * gridDim.z;
    unsigned sum, cnt, mine, sp = 0u;
    for (;;) {
        sum = 0u; cnt = 0u; mine = 0u;
#pragma unroll
        for (unsigned j = 0; j < 16; ++j) { const unsigned c = xb_ld(&bar[XB_XCNT(j)]); sum += c; cnt += (c > 0u) ? 1u : 0u; mine = (j == x) ? c : mine; }
        if (sum == G) break;
        __builtin_amdgcn_s_sleep(1);
        if ((++sp & 255u) == 0u) { if (xb_ld(&bar[XB_TMO])) break; if (sp > XB_SPIN_CAP) { atomicAdd(&bar[XB_TMO], 1u); break; } }
    }
    nloc = mine > 0u ? mine : 1u; nx = cnt > 0u ? cnt : 1u;
}

__device__ __forceinline__ void xcd_barrier(const XcdBarrier& b) {
    asm volatile("s_waitcnt vmcnt(0)" ::: "memory");
    __syncthreads();
    if (threadIdx.x == 0) {
        unsigned* bar = b.bar;
        __builtin_amdgcn_s_waitcnt(0);
        unsigned nloc = b.st[0], nx = b.st[1];
        if (nloc == 0u) { xcd_barrier_complete(bar, b.x, nloc, nx); b.st[0] = nloc; b.st[1] = nx; }
        const unsigned old = xb_add(&bar[XB_XSUB(b.x)], 1u);
        const unsigned gen = old / nloc;
        if (old + 1u == (gen + 1u) * nloc) {
            __builtin_amdgcn_fence(__ATOMIC_RELEASE, "agent");
            asm volatile("s_waitcnt vmcnt(0)" ::: "memory");
            const unsigned og = xb_add(&bar[XB_TOP], 1u);
            const unsigned tg = og / nx;
            if (og + 1u == (tg + 1u) * nx) xb_add(&bar[XB_TOPGEN], 1u);
            else XB_SPIN(xb_ld(&bar[XB_TOPGEN]) == tg, bar);
            __builtin_amdgcn_fence(__ATOMIC_ACQUIRE, "agent");
            xb_add(&bar[XB_XGEN(b.x)], 1u);
            asm volatile("s_waitcnt vmcnt(0)" ::: "memory");
        } else {
            XB_SPIN(xb_ld(&bar[XB_XGEN(b.x)]) == gen, bar);
            __builtin_amdgcn_fence(__ATOMIC_ACQUIRE, "agent");
            asm volatile("s_waitcnt vmcnt(0)" ::: "memory");
        }
    }
    __syncthreads();
}
constexpr int NWAVES = 8;
constexpr int SEQ = 8192, DM = 4096, NIN = 7232, NINP = 7424, FF = 11008, DEPTH = 2;
constexpr int A_HEADS = 12, A_KV = 4, B_HEADS = 8, C_HEADS = 12;
constexpr float EPS = 1e-6f;
#ifndef MK_PER_PHASE
#define MK_PER_PHASE 1
#endif
constexpr int N_PHASES = 1 + 8 * DEPTH;

constexpr size_t MiB = 1u << 20;
constexpr size_t WS_CTL = 0, CTL_ZERO_BYTES = 1 * MiB;
constexpr size_t WS_SSQ = 256 * 1024;
constexpr size_t WS_TCC = 2 * MiB, WS_TSC = 3 * MiB, WS_TCB = 4 * MiB, WS_TSB = 4 * MiB + 256 * 1024;
constexpr size_t WS_W0 = 8 * MiB;
constexpr size_t W_IN = 0, W_QUP = 58 * MiB, W_KVUP = 64 * MiB, W_OUT = 67 * MiB, W_GU = 99 * MiB, W_DOWN = 271 * MiB, W_LAYER = 357 * MiB;
constexpr size_t WS_ACT = WS_W0 + 2 * W_LAYER;
constexpr size_t WS_XN = WS_ACT, WS_QA = WS_XN + 64 * MiB, WS_KA = WS_QA + 24 * MiB, WS_VA = WS_KA + 8 * MiB, WS_QB = WS_VA + 8 * MiB, WS_KB = WS_QB + 16 * MiB,
                 WS_VB = WS_KB + 16 * MiB, WS_CQL = WS_VB + 16 * MiB, WS_CKVL = WS_CQL + 16 * MiB, WS_CKR = WS_CKVL + 8 * MiB, WS_QC = WS_CKR + 2 * MiB,
                 WS_KC = WS_QC + 36 * MiB, WS_VC = WS_KC + 36 * MiB, WS_Y = WS_VC + 24 * MiB, WS_ACTB = WS_Y + 64 * MiB, WS_STASH = WS_ACTB + 172 * MiB,
                 WS_END = WS_STASH + 32 * MiB;
static_assert((size_t)NINP * DM * 2 == 58 * MiB && (size_t)3072 * 1024 * 2 == 6 * MiB && (size_t)3072 * 512 * 2 == 3 * MiB && (size_t)DM * DM * 2 == 32 * MiB &&
              (size_t)2 * FF * DM * 2 == 172 * MiB && (size_t)DM * FF * 2 == 86 * MiB, "weight copy sizes");
static_assert((size_t)SEQ * FF * 2 == 172 * MiB && (size_t)SEQ * 2304 * 2 == 36 * MiB, "activation sizes");
constexpr int CW_BAR = 4096;

constexpr int RING_OFF = 0, RING_BYTES = 131072;
constexpr int EPI_OFF = RING_BYTES, EPI_BYTES = 16384;
constexpr int MISC_OFF = EPI_OFF + EPI_BYTES;
constexpr int LDS_BYTES = MISC_OFF + 512;
#ifndef CQL_PARK
#define CQL_PARK 4
#endif
static_assert(att::lds_bytes<12, CQL_PARK>() <= RING_BYTES + EPI_BYTES, "attention LDS");

typedef unsigned v2u __attribute__((ext_vector_type(2)));
__device__ __forceinline__ unsigned cvtpk2(float lo, float hi) { unsigned r; asm volatile("v_cvt_pk_bf16_f32 %0, %1, %2" : "=v"(r) : "v"(lo), "v"(hi)); return r; }

struct Args { const float* in[20]; float* out; unsigned char* ws; int ph_lo, ph_hi; float lam_init[2]; int seq, pad; };

struct Frame {
    LAS unsigned char* lds; volatile LAS unsigned* MISC;
    int tid, lane, wave, vcu, G;
};
__device__ __forceinline__ float wave_sum(float v) {
#pragma unroll
    for (int o = 1; o < 64; o <<= 1) v += __shfl_xor(v, o);
    return v;
}

template <int MAP> __device__ __forceinline__ int dest_row(int c) {
    if constexpr (MAP == 1) {
        if (c < 2048) { const int l = c & 127, hh = l >> 6, n = (l >> 5) & 1, w = (l >> 4) & 1, fq = (l >> 2) & 3, j = l & 3; return (c & ~127) + (hh * 2 + w) * 32 + fq * 8 + n * 4 + j; }
        if (c >= 2560 && c < 4608) { int l = c & 63; if (l < 16) l = ((l >> 2) & 1) * 8 + (l >> 3) * 4 + (l & 3); return (c & ~63) + l; }
        return c;
    } else if constexpr (MAP == 2) {
        const int h = c / 192, l = c - h * 192; if (l < 128) return h * 256 + l;
        const int lp = l - 128, n = lp >> 5, w = (lp >> 4) & 1, fq = (lp >> 2) & 3, j = lp & 3; return h * 256 + 128 + w * 32 + fq * 8 + n * 4 + j;
    } else if constexpr (MAP == 3) { return (c >> 7) * 256 + (c & 127);
    } else if constexpr (MAP == 4) { return (c >> 7) * 256 + 128 + (c & 127);
    } else return c;
}
template <int MAP> __device__ __forceinline__ void cvt_item(const float* __restrict__ W, int K, int N, unsigned short* WT, const float* kscale, LAS float* scr, int item, int lane) {
    const int nblk = N / 32, kb = item / nblk, nb = item % nblk, k0 = 64 * kb, n0 = 32 * nb;
#pragma unroll 8
    for (int i = 0; i < 32; ++i) { const int kk = 2 * i + (lane >> 5); float v = W[(size_t)(k0 + kk) * N + n0 + (lane & 31)]; if (kscale) v *= kscale[k0 + kk]; scr[kk * 33 + (lane & 31)] = v; }
    LDS_WAIT(); asm volatile("" ::: "memory");
    const int c = lane & 7;
#pragma unroll
    for (int j = 0; j < 4; ++j) { const int n = (lane >> 3) + 8 * j; const LAS float* s = scr + (8 * c) * 33 + n;
        v4u o; o.x = cvtpk2(s[0 * 33], s[1 * 33]); o.y = cvtpk2(s[2 * 33], s[3 * 33]); o.z = cvtpk2(s[4 * 33], s[5 * 33]); o.w = cvtpk2(s[6 * 33], s[7 * 33]);
        *(GAS v4u*)(WT + (size_t)dest_row<MAP>(n0 + n) * K + k0 + 8 * c) = o; }
    LDS_WAIT(); asm volatile("" ::: "memory");
}
template <int MAP> __device__ __forceinline__ void cvt_matrix(const Frame& F, const float* W, int K, int N, unsigned short* WT, const float* kscale) {
    LAS float* scr = (LAS float*)(F.lds + RING_OFF + F.wave * 16384);
    const int gw = F.vcu * NWAVES + F.wave, NGW = F.G * NWAVES, nitems = (K / 64) * (N / 32);
    for (int it = gw; it < nitems; it += NGW) cvt_item<MAP>(W, K, N, WT, kscale, scr, it, F.lane);
}
__device__ __forceinline__ void norm_rows(const Frame& F, const float* src, const float* gain, unsigned short* dst) {
    int lane = F.lane; asm volatile("" : "+v"(lane));
    const int gw = F.vcu * NWAVES + F.wave, NGW = F.G * NWAVES;
    for (int m = gw; m < SEQ; m += NGW) {
        const GAS f32x4* xr = (const GAS f32x4*)(src + (size_t)m * DM) + lane;
        f32x4 v[16]; float s = 0.f;
#pragma unroll
        for (int j = 0; j < 16; ++j) { v[j] = xr[64 * j]; s += (v[j].x * v[j].x + v[j].y * v[j].y) + (v[j].z * v[j].z + v[j].w * v[j].w); }
        const float rstd = rsqrtf(wave_sum(s) * (1.0f / DM) + EPS);
        GAS v2u* o8 = (GAS v2u*)(dst + (size_t)m * DM) + lane;
#pragma unroll
        for (int j = 0; j < 16; ++j) { const f32x4 g = *((const GAS f32x4*)gain + lane + 64 * j); v2u w; w.x = cvtpk2(v[j].x * rstd * g.x, v[j].y * rstd * g.y); w.y = cvtpk2(v[j].z * rstd * g.z, v[j].w * rstd * g.w); o8[64 * j] = w; }
    }
}
__device__ __forceinline__ void sincos_d(float ang, float& sn, float& cs) {
    const double a = (double)ang; const double kq = __builtin_rint(a * 0.63661977236758134308);
    double r = __builtin_fma(-kq, 1.57079632679489655800e+00, a); r = __builtin_fma(-kq, 6.12323399573676603587e-17, r);
    const int q = (int)kq & 3; const double r2 = r * r;
    const double sp = r + r * r2 * (-1.66666666666666666667e-01 + r2 * (8.33333333333333333333e-03 + r2 * (-1.98412698412698412698e-04 + r2 * (2.75573192239858906526e-06 + r2 * (-2.50521083854417187751e-08 + r2 * 1.60590438368216145994e-10)))));
    const double cp = 1.0 + r2 * (-0.5 + r2 * (4.16666666666666666667e-02 + r2 * (-1.38888888888888888889e-03 + r2 * (2.48015873015873015873e-05 + r2 * (-2.75573192239858906526e-07 + r2 * (2.08767569878680989792e-09 + r2 * -1.14707455977297247139e-11))))));
    const double s = (q & 1) ? cp : sp, c = (q & 1) ? sp : cp;
    sn = (float)((q & 2) ? -s : s); cs = (float)(((q + 1) & 2) ? -c : c);
}
__device__ __forceinline__ void rope_tables(const Frame& F, float* tcC, float* tsC, float* tcB, float* tsB) {
    const int gt = F.vcu * (NWAVES * 64) + F.tid, NT = F.G * NWAVES * 64;
    for (int e = gt; e < SEQ * 40; e += NT) {
        const bool isC = e < SEQ * 32; const int ee = isC ? e : e - SEQ * 32; const int pos = isC ? (ee >> 5) : (ee >> 3), i = isC ? (ee & 31) : (ee & 7);
        const double rr = isC ? 0.7498942093324559   : 0.19392274474868576  ;
        double p = 1.0; for (int k = 0; k < i; ++k) p *= rr;
        const float inv = (float)p, ang = (float)pos * inv; float sn, cs; sincos_d(ang, sn, cs);
        if (isC) { tcC[ee] = cs; tsC[ee] = sn; } else { tcB[ee] = cs; tsB[ee] = sn; }
    }
}

__device__ __forceinline__ int attn_unit_id(int G, int bx, int i) {
    if (G == 256) { const int x = bx & 7, r = bx >> 3;
        if (i == 0) return x * 32 + r;
        if (i == 1) return 640 + x * 48 + r;
        if (i == 2) return 256 + (x >> 1) * 96 + (x & 1) * 48 + r;
        if (i == 3) return r < 16 ? 256 + (x >> 1) * 96 + (x & 1) * 48 + 32 + r : 640 + x * 48 + 32 + (r - 16);
        return -1; }
    const int id = bx + i * G; return id < 1024 ? id : -1;
}
struct AttnPtrs { const unsigned short *QA, *KA, *VA, *QB, *KB, *VB, *QC, *KC, *VC; unsigned short* Y; float* stash; const float *lam_p, *subln; float lam_init; int seq; };
__device__ __forceinline__ void store_o_bf16(const att::f32x16 (&o)[4], unsigned short* Yw, int r32, int hi) {
#pragma unroll
    for (int r = 0; r < 16; ++r) { const int orow = att::crow(r, hi);
#pragma unroll
        for (int d0 = 0; d0 < 4; ++d0) Yw[(size_t)orow * DM + d0 * 32 + r32] = (unsigned short)(cvtpk2(o[d0][r], 0.f) & 0xffffu); }
}
__device__ __forceinline__ void attn_phase(const Frame& F, const AttnPtrs& T, char* lds) {
    for (int i = 0;; ++i) {
        const int id = attn_unit_id(F.G, (int)blockIdx.x, i); if (id < 0) break;
        int tid_ = threadIdx.x; asm volatile("" : "+v"(tid_));
        const int tid = tid_, lane = tid & 63, r32 = lane & 31, hi = lane >> 5, wid = tid >> 6;
        att::f32x16 o[4];
#ifndef ATT_MASK
#define ATT_MASK 7
#endif
        if (id < 256) { if constexpr ((ATT_MASK & 1) != 0) {
            const int h = id >> 5, t0 = (id & 31) * 256;
            float s1 = T.lam_p[lane] * T.lam_p[64 + lane], s2 = T.lam_p[128 + lane] * T.lam_p[192 + lane];
            s1 = wave_sum(s1); s2 = wave_sum(s2);
            const float lam = __builtin_amdgcn_exp2f(s1 * 1.4426950408889634f) - __builtin_amdgcn_exp2f(s2 * 1.4426950408889634f) + T.lam_init;
            constexpr float CB = 0.125f * 1.4426950408889634f, THB = att::THR / 0.125f;
            f32x4* st4 = (f32x4*)(T.stash + (size_t)blockIdx.x * 32768 + tid * 64);
            att::attn_pass<4, 1, 0, true, 1024, 1024, 1024>(T.QB + (size_t)t0 * 1024 + (2 * h) * 64, T.KB + (2 * h) * 64, T.VB + h * 128, T.seq, lds, CB, THB, o);
#pragma unroll
            for (int d0 = 0; d0 < 4; ++d0)
#pragma unroll
                for (int rg = 0; rg < 4; ++rg) st4[d0 * 4 + rg] = (f32x4){o[d0][4 * rg], o[d0][4 * rg + 1], o[d0][4 * rg + 2], o[d0][4 * rg + 3]};
            asm volatile("" ::: "memory");
            att::attn_pass<4, 1, 0, true, 1024, 1024, 1024>(T.QB + (size_t)t0 * 1024 + (2 * h + 1) * 64, T.KB + (2 * h + 1) * 64, T.VB + h * 128, T.seq, lds, CB, THB, o);
            const float post = 1.0f - T.lam_init;
            float g[4];
#pragma unroll
            for (int d0 = 0; d0 < 4; ++d0) g[d0] = T.subln[d0 * 32 + r32] * post;
#pragma unroll
            for (int rg = 0; rg < 4; ++rg) { f32x4 s1v[4];
#pragma unroll
                for (int d0 = 0; d0 < 4; ++d0) s1v[d0] = st4[d0 * 4 + rg];
#pragma unroll
                for (int k = 0; k < 4; ++k) { const int r = 4 * rg + k; float q = 0.f;
#pragma unroll
                    for (int d0 = 0; d0 < 4; ++d0) { const float v = s1v[d0][k] - lam * o[d0][r]; o[d0][r] = v; q += v * v; }
                    q += __shfl_xor(q, 1); q += __shfl_xor(q, 2); q += __shfl_xor(q, 4); q += __shfl_xor(q, 8); q += __shfl_xor(q, 16);
                    const float rstd = rsqrtf(q * (1.0f / 128.0f) + EPS);
#pragma unroll
                    for (int d0 = 0; d0 < 4; ++d0) o[d0][r] = o[d0][r] * rstd * g[d0]; }
                asm volatile("" ::: "memory"); }
            store_o_bf16(o, T.Y + (size_t)(t0 + wid * 32) * DM + 1536 + h * 128, r32, hi);
        } } else if (id < 640) { if constexpr ((ATT_MASK & 2) != 0) {
            const int a = id - 256, kvg = a / 96, rem = a - kvg * 96, h = kvg * 3 + (rem >> 5), t0 = (rem & 31) * 256;
            constexpr float CA = 0.088388347648318440f * 1.4426950408889634f, THA = att::THR / 0.088388347648318440f;
            att::attn_pass<8, 1, 0, true, 1536, 512, 512>(T.QA + (size_t)t0 * 1536 + h * 128, T.KA + kvg * 128, T.VA + kvg * 128, T.seq, lds, CA, THA, o);
            store_o_bf16(o, T.Y + (size_t)(t0 + wid * 32) * DM + h * 128, r32, hi);
        } } else { if constexpr ((ATT_MASK & 4) != 0) {
            const int c = id - 640, h = c >> 5, t0 = (c & 31) * 256;
            constexpr float CC = 0.072168783648703220f * 1.4426950408889634f, THC = att::THR / 0.072168783648703220f;
            att::attn_pass<12, 1, CQL_PARK, false, 2304, 2304, 1536>(T.QC + (size_t)t0 * 2304 + h * 192, T.KC + h * 192, T.VC + h * 128, T.seq, lds, CC, THC, o);
            store_o_bf16(o, T.Y + (size_t)(t0 + wid * 32) * DM + 2560 + h * 128, r32, hi);
        } }
    }
}

__global__ void __launch_bounds__(NWAVES * 64, 2) hybrid_fwd(Args args) {
    extern __shared__ __attribute__((aligned(16))) unsigned char lds[];
    Frame F;
    F.lds = (LAS unsigned char*)lds; F.MISC = (volatile LAS unsigned*)(F.lds + MISC_OFF);
    F.tid = threadIdx.x; F.lane = F.tid & 63; F.wave = __builtin_amdgcn_readfirstlane(F.tid >> 6);
    F.G = gridDim.x; { const int bx = blockIdx.x; F.vcu = (F.G % 8 == 0) ? (bx % 8) * (F.G / 8) + bx / 8 : bx; }
    unsigned char* ws = args.ws;
    for (int u = F.tid; u < (LDS_BYTES - MISC_OFF) / 4; u += NWAVES * 64) ((LAS unsigned*)(F.lds + MISC_OFF))[u] = 0u;
    __syncthreads();
    XcdBarrier bar; bar.bar = (unsigned*)(ws + WS_CTL) + CW_BAR; bar.x = 0; bar.st = nullptr;
    if (!MK_PER_PHASE) bar = xcd_barrier_post((unsigned*)(ws + WS_CTL) + CW_BAR, F.MISC + 8);
    const int lo = args.ph_lo, hi = args.ph_hi;
#ifndef PH_MASK
#define PH_MASK 0x1ff
#endif
#define PK(b) (((PH_MASK) >> (b)) & 1)
#define IN(k) (lo <= (k) && (k) < hi)
#define SEAM(k) do { if (!MK_PER_PHASE && IN(k) && IN((k) + 1)) xcd_barrier(bar); } while (0)
    typedef unsigned short bf;
    float* tcC = (float*)(ws + WS_TCC); float* tsC = (float*)(ws + WS_TSC); float* tcB = (float*)(ws + WS_TCB); float* tsB = (float*)(ws + WS_TSB);
    bf* XN = (bf*)(ws + WS_XN); bf* QA = (bf*)(ws + WS_QA); bf* KA = (bf*)(ws + WS_KA); bf* VA = (bf*)(ws + WS_VA); bf* QB = (bf*)(ws + WS_QB); bf* KB = (bf*)(ws + WS_KB); bf* VB = (bf*)(ws + WS_VB);
    bf* CQL = (bf*)(ws + WS_CQL); bf* CKVL = (bf*)(ws + WS_CKVL); float* CKR = (float*)(ws + WS_CKR); bf* QC = (bf*)(ws + WS_QC); bf* KC = (bf*)(ws + WS_KC); bf* VC = (bf*)(ws + WS_VC);
    bf* Y = (bf*)(ws + WS_Y); bf* ACT = (bf*)(ws + WS_ACTB); float* STASH = (float*)(ws + WS_STASH);
    PG8_LAS float* EP = (PG8_LAS float*)(F.lds + EPI_OFF);
    PG8_LAS unsigned char* ring = (PG8_LAS unsigned char*)(F.lds + RING_OFF);

    if (PK(0) && IN(0)) {
        for (int l = 0; l < DEPTH; ++l) {
            unsigned char* wl = ws + WS_W0 + (size_t)l * W_LAYER;
            cvt_matrix<1>(F, args.in[2] + (size_t)l * DM * NIN, DM, NIN, (bf*)(wl + W_IN), nullptr);
            cvt_matrix<2>(F, args.in[11] + (size_t)l * 1024 * 2304, 1024, 2304, (bf*)(wl + W_QUP), args.in[9] + l * 1024);
            cvt_matrix<0>(F, args.in[12] + (size_t)l * 512 * 3072, 512, 3072, (bf*)(wl + W_KVUP), args.in[10] + l * 512);
            cvt_matrix<0>(F, args.in[15] + (size_t)l * DM * DM, DM, DM, (bf*)(wl + W_OUT), nullptr);
            cvt_matrix<3>(F, args.in[17] + (size_t)l * DM * FF, DM, FF, (bf*)(wl + W_GU), nullptr);
            cvt_matrix<4>(F, args.in[18] + (size_t)l * DM * FF, DM, FF, (bf*)(wl + W_GU), nullptr);
            cvt_matrix<0>(F, args.in[19] + (size_t)l * FF * DM, FF, DM, (bf*)(wl + W_DOWN), nullptr);
        }
        rope_tables(F, tcC, tsC, tcB, tsB);
        norm_rows(F, args.in[0], args.in[1], XN);
    }
    SEAM(0);
    for (int l = 0; l < DEPTH; ++l) {
        const int pb = 1 + 8 * l;
        unsigned char* wl = ws + WS_W0 + (size_t)l * W_LAYER;
        float* SSQ = (float*)(ws + WS_SSQ) + (size_t)l * 3 * SEQ;
        const float* hin = (l == 0) ? args.in[0] : args.out;
        if (PK(1) && IN(pb + 0)) { __builtin_amdgcn_s_waitcnt(0);
            pg8::Gemm g{XN, (const bf*)(wl + W_IN), SEQ, NINP, DM}; pg8::StaticOrder S; S.init(SEQ, NINP, F.G, (int)blockIdx.x);
            pg8::EpiInProj E{QA, KA, VA, QB, KB, VB, CQL, CKVL, CKR, SSQ, SSQ + SEQ, SSQ + 2 * SEQ,
                             args.in[3] + l * 128, args.in[4] + l * 128, args.in[5] + l * 64, args.in[6] + l * 64, tcC, tsC, tcB, tsB, EP};
            pg8::gemm_phase<pg8::EpiInProj, pg8::StaticOrder, true, true>(ring, g, S, E);
        }
        SEAM(pb + 0);
        if (PK(2) && IN(pb + 1)) { __builtin_amdgcn_s_waitcnt(0);
            { pg8::Gemm g{CQL, (const bf*)(wl + W_QUP), SEQ, 3072, 1024}; pg8::StaticOrder S; S.init(SEQ, 3072, F.G, (int)blockIdx.x);
              pg8::EpiQUp E{QC, SSQ, args.in[13] + l * 192, tcC, tsC, EP};
              pg8::gemm_phase<pg8::EpiQUp, pg8::StaticOrder, true, true>(ring, g, S, E); }
            { pg8::Gemm g{CKVL, (const bf*)(wl + W_KVUP), SEQ, 3072, 512}; pg8::StaticOrder S; S.init(SEQ, 3072, F.G, (int)blockIdx.x);
              pg8::EpiKVUp E{KC, VC, SSQ + SEQ, SSQ + 2 * SEQ, CKR, args.in[14] + l * 192, tcC, tsC, EP};
              pg8::gemm_phase<pg8::EpiKVUp, pg8::StaticOrder, true, true>(ring, g, S, E); }
        }
        SEAM(pb + 1);
        if (PK(3) && IN(pb + 2)) { __builtin_amdgcn_s_waitcnt(0);
            const AttnPtrs T{QA, KA, VA, QB, KB, VB, QC, KC, VC, Y, STASH, args.in[7] + l * 256, args.in[8] + l * 128, args.lam_init[l], args.seq};
            attn_phase(F, T, (char*)lds + RING_OFF);
        }
        SEAM(pb + 2);
        if (PK(4) && IN(pb + 3)) { __builtin_amdgcn_s_waitcnt(0);
            pg8::Gemm g{Y, (const bf*)(wl + W_OUT), SEQ, DM, DM}; pg8::StaticOrder S; S.init(SEQ, DM, F.G, (int)blockIdx.x);
            pg8::EpiResid E{hin, args.out, DM};
            pg8::gemm_phase<pg8::EpiResid, pg8::StaticOrder, true, true>(ring, g, S, E);
        }
        SEAM(pb + 3);
        if (PK(5) && IN(pb + 4)) norm_rows(F, args.out, args.in[16] + l * DM, XN);
        SEAM(pb + 4);
        if (PK(6) && IN(pb + 5)) { __builtin_amdgcn_s_waitcnt(0);
            pg8::Gemm g{XN, (const bf*)(wl + W_GU), SEQ, 2 * FF, DM}; pg8::StaticOrder S; S.init(SEQ, 2 * FF, F.G, (int)blockIdx.x);
            pg8::EpiGateUp E{ACT, FF};
            pg8::gemm_phase<pg8::EpiGateUp, pg8::StaticOrder, true, true>(ring, g, S, E);
        }
        SEAM(pb + 5);
        if (PK(7) && IN(pb + 6)) { __builtin_amdgcn_s_waitcnt(0);
            pg8::Gemm g{ACT, (const bf*)(wl + W_DOWN), SEQ, DM, FF}; pg8::StaticOrder S; S.init(SEQ, DM, F.G, (int)blockIdx.x);
            pg8::EpiResid E{args.out, args.out, DM};
            pg8::gemm_phase<pg8::EpiResid, pg8::StaticOrder, true, true>(ring, g, S, E);
        }
        if (l + 1 < DEPTH) SEAM(pb + 6);
        if (PK(8) && IN(pb + 7) && l + 1 < DEPTH) norm_rows(F, args.out, args.in[1] + (l + 1) * DM, XN);
        if (l + 1 < DEPTH) SEAM(pb + 7);
    }
#undef IN
#undef SEAM
#undef PK
}

extern "C" void kernel_launch(void* const* d_in, const int* in_sizes, int n_in, void* d_out, int out_size, void* d_ws, size_t ws_size, hipStream_t stream) {
    static int grid = 0;
    if (grid == 0) {
        if (n_in != 20 || in_sizes[0] != SEQ * DM || out_size != SEQ * DM || ws_size < WS_END) {
            fprintf(stderr, "kernel_launch: unexpected shapes: n_in %d in0 %d out %d ws %zu (need %zu); nothing launched\n", n_in, n_in > 0 ? in_sizes[0] : -1, out_size, ws_size, (size_t)WS_END); grid = -1; return; }
        int dev = 0, cus = 0, per_cu = 0;
        if (hipGetDevice(&dev) != hipSuccess || hipDeviceGetAttribute(&cus, hipDeviceAttributeMultiprocessorCount, dev) != hipSuccess) { fprintf(stderr, "kernel_launch: device query failed\n"); grid = -1; return; }
        if (hipFuncSetAttribute((const void*)hybrid_fwd, hipFuncAttributeMaxDynamicSharedMemorySize, LDS_BYTES) != hipSuccess) { fprintf(stderr, "kernel_launch: hipFuncSetAttribute failed\n"); grid = -1; return; }
        if (hipOccupancyMaxActiveBlocksPerMultiprocessor(&per_cu, (const void*)hybrid_fwd, NWAVES * 64, LDS_BYTES) != hipSuccess || per_cu < 1)
            fprintf(stderr, "kernel_launch: note: occupancy query reports %d workgroups per CU\n", per_cu);
        (void)hipGetLastError();
        grid = cus;
    }
    if (grid < 0) return;
    if (hipMemsetAsync((char*)d_ws + WS_CTL, 0, CTL_ZERO_BYTES, stream) != hipSuccess) { fprintf(stderr, "kernel_launch: hipMemsetAsync failed\n"); return; }
    Args a{};
    for (int i = 0; i < 20; ++i) a.in[i] = (const float*)d_in[i];
    a.out = (float*)d_out; a.ws = (unsigned char*)d_ws;
    a.seq = SEQ; a.pad = 0; a.lam_init[0] = 0.2f; a.lam_init[1] = (float)(0.8 - 0.6 * 0.74081822068171786607);
#if MK_PER_PHASE
    for (int p = 0; p < N_PHASES; ++p) { a.ph_lo = p; a.ph_hi = p + 1; hipLaunchKernelGGL(hybrid_fwd, dim3(grid), dim3(NWAVES * 64), LDS_BYTES, stream, a); }
#else
    a.ph_lo = 0; a.ph_hi = N_PHASES;
    hipLaunchKernelGGL(hybrid_fwd, dim3(grid), dim3(NWAVES * 64), LDS_BYTES, stream, a);
#endif
    const hipError_t le = hipPeekAtLastError();
    if (le != hipSuccess) fprintf(stderr, "kernel_launch: launch failed: %s\n", hipGetErrorName(le));
}
```

```cpp
#include <hip/hip_runtime.h>
#include <cstdio>
#include <cstdint>
__device__ __forceinline__ int fresh_lane() { int l; asm volatile("v_mbcnt_lo_u32_b32 %0, -1, 0\n\tv_mbcnt_hi_u32_b32 %0, -1, %0" : "=v"(l)); return l; }
namespace pg8 {
#define PG8_LAS __attribute__((address_space(3)))
typedef unsigned short bf16_t;
typedef short bf16x8 __attribute__((ext_vector_type(8)));
typedef float f32x4 __attribute__((ext_vector_type(4)));
typedef unsigned u32x4 __attribute__((ext_vector_type(4)));
constexpr int BM = 256, BK = 64, HALF = 128, HTB = HALF * BK * 2  , STAGE_BYTES = 8 * HTB, NXCD = 8, WGM = 8;

__host__ __device__ __forceinline__ int lds_byte(int r, int c) { const int st = (r >> 4) * 2 + (c >> 5), rr = r & 15, cc = c & 31, ob = rr * 64 + cc * 2; return st * 1024 + (ob ^ (((ob >> 9) & 1) << 5)); }
__host__ __device__ __forceinline__ void stage_rc(int b, int& R, int& C) { const int st = b / 1024, sb = b % 1024, swz = sb ^ (((sb >> 9) & 1) << 5); R = (st >> 1) * 16 + swz / 64; C = (st & 1) * 32 + (swz % 64) / 2; }
__host__ __device__ __forceinline__ int perm32(int rho) { const int n = rho >> 4, i = rho & 15; return 8 * (i >> 2) + 4 * n + (i & 3); }

__device__ __forceinline__ __amdgpu_buffer_rsrc_t pg8_srd(const void* p, unsigned bytes) {
    const unsigned long long q = (unsigned long long)p;
    const unsigned lo = __builtin_amdgcn_readfirstlane((unsigned)q), hi = __builtin_amdgcn_readfirstlane((unsigned)(q >> 32));
    return __builtin_amdgcn_make_buffer_rsrc((void*)(((unsigned long long)hi << 32) | lo), (short)0, (int)bytes, 0x00020000);
}
struct Unit { int pm, pn; };
struct Gemm { const bf16_t* A; const bf16_t* Bt; int M, N, K; };

#ifndef PG8_ROT
#define PG8_ROT 0
#endif
struct StaticOrder {
    int nM, nN, nwg, G, c;
    __host__ __device__ void init(int M, int N, int G_, int c_) { nM = M / BM; nN = N / BM; nwg = nM * nN; G = G_; c = c_; }
    __host__ __device__ bool next(int i, Unit& u) const {
        const long L = (long)i * G + c; if (L >= nwg) return false;
        int wgid = (int)L; { const int q = nwg / NXCD, r = nwg % NXCD, xcd = wgid % NXCD; int off = wgid / NXCD;
            if (PG8_ROT && r == 0) off = (off + ((xcd >> 1) * 32) % q) % q;
            wgid = (xcd < r ? xcd * (q + 1) : r * (q + 1) + (xcd - r) * q) + off; }
        const int nig = WGM * nN, gid = wgid / nig, fm = gid * WGM, gsz = (nM - fm) < WGM ? (nM - fm) : WGM;
        u.pm = fm + ((wgid % nig) % gsz); u.pn = (wgid % nig) / gsz; return true;
    }
    __device__ __forceinline__ void a_ready(const Unit&) const {}
    __device__ __forceinline__ void done(const Unit&) const {}
};

template <class Epi, class Sched, bool ALIGN_EPI = false, bool SP2 = false>
__device__ __forceinline__ void gemm_phase(PG8_LAS unsigned char* lds, const Gemm g, const Sched& S, const Epi& E, const int wave_  ) {
    int wv_ = wave_; asm volatile("" : "+s"(wv_));
    int tid_ = wv_ * 64 + fresh_lane();
    const int tid = tid_, wid = wv_, lane = tid & 63, wr = wid >> 2, wc = wid & 3, fr = lane & 15, fq = lane >> 4;
    const int K = g.K, nt = K / BK;
    unsigned voffA[2], voffB[2];
#pragma unroll
    for (int i = 0; i < 2; ++i) { int R, C; stage_rc(tid * 16 + i * 8192, R, C); const int Rb = Epi::PERM ? ((R & ~31) + perm32(R & 31)) : R;
        voffA[i] = (unsigned)(R * K + C) * 2u; voffB[i] = (unsigned)(Rb * K + C) * 2u; }
    const unsigned kstep = (unsigned)(BK * 2);
    const unsigned hstep = (unsigned)HALF * (unsigned)K * 2u;
    const unsigned tstep = 2u * hstep;
    const char* base_ = (const char*)g.A < (const char*)g.Bt ? (const char*)g.A : (const char*)g.Bt;
    const unsigned offA = (unsigned)((const char*)g.A - base_), offB = (unsigned)((const char*)g.Bt - base_);
    const __amdgpu_buffer_rsrc_t srdA = pg8_srd(base_, 0xFFFFF000u);
    const unsigned ldsw = (unsigned)wid * 1024u;
    const int aoff = lds_byte(wr * 64 + fr, fq * 8), boff = lds_byte(wc * 32 + fr, fq * 8);
#define PG8_SA(b, h) (((b) * 2 + (h)) * HTB)
#define PG8_SB(b, h) ((4 + (b) * 2 + (h)) * HTB)
#define PG8_STAGE(bufoff, gbase, voff) do { _Pragma("unroll") for (int _i = 0; _i < 2; ++_i) \
        __builtin_amdgcn_raw_ptr_buffer_load_lds(PG8_SRD_OF_##voff, (PG8_LAS void*)(lds + (bufoff) + ldsw + _i * 8192), 16, (int)(voff)[_i], (int)(gbase), 0, 0); } while (0)
#define PG8_SRD_OF_voffA srdA
#define PG8_SRD_OF_voffB srdA
#define PG8_LDA(dst, b, h) do { _Pragma("unroll") for (int m = 0; m < 4; ++m) _Pragma("unroll") for (int k = 0; k < 2; ++k) dst[m][k] = *(const PG8_LAS bf16x8*)(lds + PG8_SA(b, h) + aoff + m * 2048 + k * 1024); } while (0)
#define PG8_LDB(dst, b, h) do { _Pragma("unroll") for (int n = 0; n < 2; ++n) _Pragma("unroll") for (int k = 0; k < 2; ++k) dst[n][k] = *(const PG8_LAS bf16x8*)(lds + PG8_SB(b, h) + boff + n * 2048 + k * 1024); } while (0)
#define PG8_MMA(ai, bj, At, Bt) do { __builtin_amdgcn_s_setprio(1); _Pragma("unroll") for (int m = 0; m < 4; ++m) _Pragma("unroll") for (int n = 0; n < 2; ++n) _Pragma("unroll") for (int k = 0; k < 2; ++k) \
        acc[ai][bj][m][n] = __builtin_amdgcn_mfma_f32_16x16x32_bf16(Bt[n][k], At[m][k], acc[ai][bj][m][n], 0, 0, 0); __builtin_amdgcn_s_setprio(0); } while (0)
#define PG8_WAIT_V(n) asm volatile("s_waitcnt vmcnt(" #n ")" ::: "memory")
#define PG8_WAIT_L(n) asm volatile("s_waitcnt lgkmcnt(" #n ")" ::: "memory")
#define PG8_BAR __builtin_amdgcn_s_barrier()
#define PG8_SCHED __builtin_amdgcn_sched_barrier(0)
    Unit cur, nxt; int ui = 0;
    if (!S.next(0, cur)) return;
    f32x4 acc[2][2][4][2];
#pragma unroll
    for (int a = 0; a < 2; ++a)
#pragma unroll
        for (int b = 0; b < 2; ++b)
#pragma unroll
            for (int m = 0; m < 4; ++m)
#pragma unroll
                for (int n = 0; n < 2; ++n) acc[a][b][m][n] = (f32x4){0.f, 0.f, 0.f, 0.f};
    bf16x8 At[4][2], B0[2][2], B1[2][2];
    unsigned cA = offA + (unsigned)cur.pm * tstep, cB = offB + (unsigned)cur.pn * tstep;
    S.a_ready(cur);
    if constexpr (SP2) {
        PG8_STAGE(PG8_SB(0, 0), cB, voffB); PG8_STAGE(PG8_SB(0, 1), cB + hstep, voffB); PG8_STAGE(PG8_SA(0, 0), cA, voffA); PG8_STAGE(PG8_SA(0, 1), cA + hstep, voffA);
        if (wr == 1) PG8_BAR;
        PG8_WAIT_V(2); PG8_BAR;
        PG8_STAGE(PG8_SB(1, 0), cB + kstep, voffB); PG8_STAGE(PG8_SA(1, 0), cA + kstep, voffA); PG8_STAGE(PG8_SB(1, 1), cB + hstep + kstep, voffB);
        PG8_WAIT_V(6); PG8_BAR;
    } else {
        PG8_STAGE(PG8_SB(0, 0), cB, voffB); PG8_STAGE(PG8_SA(0, 0), cA, voffA); PG8_STAGE(PG8_SB(0, 1), cB + hstep, voffB); PG8_STAGE(PG8_SA(0, 1), cA + hstep, voffA);
        if (wr == 1) PG8_BAR;
        PG8_WAIT_V(4); PG8_BAR;
        PG8_STAGE(PG8_SB(1, 0), cB + kstep, voffB); PG8_STAGE(PG8_SA(1, 0), cA + kstep, voffA); PG8_STAGE(PG8_SB(1, 1), cB + hstep + kstep, voffB);
        PG8_WAIT_V(6); PG8_BAR;
    }
    for (;;) {
        const bool has_next = S.next(ui + 1, nxt);
        const unsigned nA = has_next ? offA + (unsigned)nxt.pm * tstep : cA, nB = has_next ? offB + (unsigned)nxt.pn * tstep : cB;
        for (int t = 0; t < nt; t += 2) {
            const bool last = (t == nt - 2);
            const unsigned a1 = cA + (unsigned)(t + 1) * kstep;
            const unsigned a2 = last ? nA : cA + (unsigned)(t + 2) * kstep, b2 = last ? nB : cB + (unsigned)(t + 2) * kstep;
            const unsigned a3 = a2 + kstep, b3 = b2 + kstep;
            if (last && has_next) S.a_ready(nxt);
            if constexpr (SP2) {
            PG8_LDB(B0, 0, 0); PG8_LDB(B1, 0, 1); PG8_SCHED; PG8_LDA(At, 0, 0); PG8_STAGE(PG8_SA(1, 1), a1 + hstep, voffA);
            PG8_WAIT_V(8); PG8_WAIT_L(0); PG8_BAR; PG8_MMA(0, 0, At, B0); PG8_MMA(0, 1, At, B1); PG8_BAR; PG8_SCHED;
            PG8_LDA(At, 0, 1); PG8_STAGE(PG8_SB(0, 0), b2, voffB); PG8_STAGE(PG8_SB(0, 1), b2 + hstep, voffB); PG8_STAGE(PG8_SA(0, 0), a2, voffA);
            PG8_WAIT_V(8); PG8_WAIT_L(0); PG8_BAR; PG8_MMA(1, 0, At, B0); PG8_MMA(1, 1, At, B1); PG8_BAR; PG8_SCHED;
            PG8_LDB(B0, 1, 0); PG8_LDB(B1, 1, 1); PG8_SCHED; PG8_LDA(At, 1, 0); PG8_STAGE(PG8_SA(0, 1), a2 + hstep, voffA);
            PG8_WAIT_V(8); PG8_WAIT_L(0); PG8_BAR; PG8_MMA(0, 0, At, B0); PG8_MMA(0, 1, At, B1); PG8_BAR; PG8_SCHED;
            PG8_LDA(At, 1, 1); PG8_STAGE(PG8_SB(1, 0), b3, voffB); PG8_STAGE(PG8_SB(1, 1), b3 + hstep, voffB); PG8_STAGE(PG8_SA(1, 0), a3, voffA);
            PG8_WAIT_V(8); PG8_WAIT_L(0); PG8_BAR; PG8_MMA(1, 0, At, B0); PG8_MMA(1, 1, At, B1); PG8_BAR; PG8_SCHED;
            } else {
            PG8_LDB(B0, 0, 0); PG8_SCHED; PG8_LDA(At, 0, 0); PG8_STAGE(PG8_SA(1, 1), a1 + hstep, voffA);
            PG8_WAIT_L(8); PG8_BAR; PG8_WAIT_L(0); PG8_MMA(0, 0, At, B0); PG8_BAR; PG8_SCHED;
            PG8_LDB(B1, 0, 1); PG8_STAGE(PG8_SB(0, 0), b2, voffB);
            PG8_BAR; PG8_WAIT_L(0); PG8_MMA(0, 1, At, B1); PG8_BAR;
            PG8_LDA(At, 0, 1); PG8_STAGE(PG8_SA(0, 0), a2, voffA);
            PG8_BAR; PG8_WAIT_L(0); PG8_MMA(1, 0, At, B0); PG8_BAR; PG8_SCHED;
            PG8_STAGE(PG8_SB(0, 1), b2 + hstep, voffB);
            PG8_WAIT_V(6); PG8_BAR; PG8_MMA(1, 1, At, B1); PG8_BAR;
            PG8_LDB(B0, 1, 0); PG8_SCHED; PG8_LDA(At, 1, 0); PG8_STAGE(PG8_SA(0, 1), a2 + hstep, voffA);
            PG8_WAIT_L(8); PG8_BAR; PG8_WAIT_L(0); PG8_MMA(0, 0, At, B0); PG8_BAR; PG8_SCHED;
            PG8_LDB(B1, 1, 1); PG8_STAGE(PG8_SB(1, 0), b3, voffB);
            PG8_BAR; PG8_WAIT_L(0); PG8_MMA(0, 1, At, B1); PG8_BAR;
            PG8_LDA(At, 1, 1); PG8_STAGE(PG8_SA(1, 0), a3, voffA);
            PG8_BAR; PG8_WAIT_L(0); PG8_MMA(1, 0, At, B0); PG8_BAR; PG8_SCHED;
            PG8_STAGE(PG8_SB(1, 1), b3 + hstep, voffB);
            PG8_WAIT_V(6); PG8_BAR; PG8_MMA(1, 1, At, B1); PG8_BAR;
            }
        }
        if constexpr (ALIGN_EPI) { if (wr == 0) PG8_BAR; }
        if constexpr (!Epi::AFTER_DRAIN) { E(acc, cur, wr, wc, fr, fq); S.done(cur); }
        if (!has_next) break;
#pragma unroll
        for (int a = 0; a < 2; ++a)
#pragma unroll
            for (int b = 0; b < 2; ++b)
#pragma unroll
                for (int m = 0; m < 4; ++m)
#pragma unroll
                    for (int n = 0; n < 2; ++n) acc[a][b][m][n] = (f32x4){0.f, 0.f, 0.f, 0.f};
        cur = nxt; cA = nA; cB = nB; ++ui;
        if constexpr (ALIGN_EPI) { if (wr == 1) PG8_BAR; }
    }
    PG8_WAIT_V(0);
    if constexpr (!ALIGN_EPI) { if (wr == 0) PG8_BAR; }
    PG8_BAR;
    if constexpr (Epi::AFTER_DRAIN) { E.fused(acc, cur, wr, wc, fr, fq, lds, wid, lane); S.done(cur); }
#undef PG8_SA
#undef PG8_SB
#undef PG8_STAGE
#undef PG8_LDA
#undef PG8_LDB
#undef PG8_MMA
#undef PG8_WAIT_V
#undef PG8_WAIT_L
#undef PG8_BAR
#undef PG8_SCHED
}
}
namespace pg8 {
constexpr float RMS_EPS = 1e-6f;
__device__ __forceinline__ unsigned cvt_pk_bf16(float lo, float hi) { unsigned r; asm volatile("v_cvt_pk_bf16_f32 %0, %1, %2" : "=v"(r) : "v"(lo), "v"(hi)); return r; }
__device__ __forceinline__ u32x4 pack8(const f32x4 a, const f32x4 b) { u32x4 w; w.x = cvt_pk_bf16(a[0], a[1]); w.y = cvt_pk_bf16(a[2], a[3]); w.z = cvt_pk_bf16(b[0], b[1]); w.w = cvt_pk_bf16(b[2], b[3]); return w; }
__device__ __forceinline__ float dot4(const f32x4 a) { return (a[0] * a[0] + a[1] * a[1]) + (a[2] * a[2] + a[3] * a[3]); }
__device__ __forceinline__ float fq_sum(float s) { s += __shfl_xor(s, 16); s += __shfl_xor(s, 32); return s; }
#define PG8_EPI_BAR() do { asm volatile("s_waitcnt lgkmcnt(0)" ::: "memory"); __builtin_amdgcn_s_barrier(); asm volatile("" ::: "memory"); } while (0)
typedef float f32x4a __attribute__((ext_vector_type(4)));

struct EpiInProj {
    static constexpr bool PERM = true, AFTER_DRAIN = false;
    bf16_t *QA, *KA, *VA, *QB, *KB, *VB, *CQL, *CKVL; float* CKR; float *SSQ_Q, *SSQ_KV, *SSQ_KR;
    const float *gaq, *gak, *gbq, *gbk;
    const float *tcC, *tsC, *tcB, *tsB;
    PG8_LAS float* P;
    const float* SSQ_H;
    __device__ __forceinline__ float row_rs(int t) const { return rsqrtf(SSQ_H[t] * (1.0f / 4096.0f) + RMS_EPS); }
    __device__ __forceinline__ void row_rs8(int row0, float (&rs)[2][4]) const {
        float q[2][4];
#pragma unroll
        for (int ai = 0; ai < 2; ++ai)
#pragma unroll
            for (int m = 0; m < 4; ++m) q[ai][m] = SSQ_H[row0 + ai * HALF + m * 16];
        asm volatile("" : "+v"(q[0][0]), "+v"(q[0][1]), "+v"(q[0][2]), "+v"(q[0][3]), "+v"(q[1][0]), "+v"(q[1][1]), "+v"(q[1][2]), "+v"(q[1][3]));
#pragma unroll
        for (int ai = 0; ai < 2; ++ai)
#pragma unroll
            for (int m = 0; m < 4; ++m) rs[ai][m] = rsqrtf(q[ai][m] * (1.0f / 4096.0f) + RMS_EPS);
    }
    __device__ __forceinline__ void plain(const f32x4 (&acc)[2][2][4][2], int row0, int wc, int fq, bf16_t* dst, int ld, const float (&rs8)[2][4]) const {
#pragma unroll
        for (int ai = 0; ai < 2; ++ai)
#pragma unroll
            for (int m = 0; m < 4; ++m) { const int t = row0 + ai * HALF + m * 16; const float rs = rs8[ai][m]; bf16_t* rowp = dst + (size_t)t * ld + wc * 32 + 8 * fq;
#pragma unroll
                for (int bj = 0; bj < 2; ++bj) *(u32x4*)(rowp + bj * HALF) = pack8(acc[ai][bj][m][0] * rs, acc[ai][bj][m][1] * rs); }
    }
    __device__ __forceinline__ void row_ssq(const f32x4 (&acc)[2][2][4][2], int row0, int fq, float* ssq, bool both, const float (&rs8)[2][4]) const {
#pragma unroll
        for (int ai = 0; ai < 2; ++ai)
#pragma unroll
            for (int m = 0; m < 4; ++m) { float s = dot4(acc[ai][0][m][0]) + dot4(acc[ai][0][m][1]); if (both) s += dot4(acc[ai][1][m][0]) + dot4(acc[ai][1][m][1]);
                s = fq_sum(s); const int t = row0 + ai * HALF + m * 16; const float rs = rs8[ai][m]; if (fq == 0) __hip_atomic_fetch_add(ssq + t, s * rs * rs, __ATOMIC_RELAXED, __HIP_MEMORY_SCOPE_AGENT); }
    }
    __device__ __forceinline__ void partials(const f32x4 (&acc)[2][2][4][2], int wr, int wc, int fr, int fq) const {
#pragma unroll
        for (int ai = 0; ai < 2; ++ai)
#pragma unroll
            for (int m = 0; m < 4; ++m)
#pragma unroll
                for (int bj = 0; bj < 2; ++bj) { float s = dot4(acc[ai][bj][m][0]) + dot4(acc[ai][bj][m][1]); s = fq_sum(s);
                    if (fq == 0) P[(ai * HALF + wr * 64 + m * 16 + fr) * 8 + bj * 4 + wc] = s; }
    }
    __device__ __forceinline__ void operator()(const f32x4 (&acc)[2][2][4][2], const Unit& u, int wr, int wc, int fr_, int fq_) const {
        int fr = fr_, fq = fq_; asm volatile("" : "+v"(fr), "+v"(fq));
        const int pn = u.pn, row0 = u.pm * BM + wr * 64 + fr;
        float rs8[2][4]; row_rs8(row0, rs8);
        if (pn < 8) {
            bf16_t* dst = pn < 6 ? QA + pn * 256 : KA + (pn - 6) * 256; const int ld = pn < 6 ? 1536 : 512; const float* gain = pn < 6 ? gaq : gak;
            const float qs = pn < 6 ? 0.088388347648318440f * 1.4426950408889634f : 1.0f;
            partials(acc, wr, wc, fr, fq); PG8_EPI_BAR();
            const int hh = wc >> 1, i0 = (wc & 1) * 16 + fq * 4;
            const f32x4 g1 = *(const f32x4*)(gain + hh * 64 + i0), g2 = *(const f32x4*)(gain + hh * 64 + 32 + i0);
#pragma unroll
            for (int ai = 0; ai < 2; ++ai)
#pragma unroll
                for (int m = 0; m < 4; ++m) { const int rl = ai * HALF + wr * 64 + m * 16 + fr, t = u.pm * BM + rl;
                    const f32x4 pa = *(const PG8_LAS f32x4*)(P + rl * 8), pb = *(const PG8_LAS f32x4*)(P + rl * 8 + 4);
                    const float rs = rs8[ai][m], rs2 = rs * rs * (1.0f / 128.0f);
                    const float r0 = qs * rs * rsqrtf(((pa[0] + pa[1]) + (pa[2] + pa[3])) * rs2 + RMS_EPS), r1 = qs * rs * rsqrtf(((pb[0] + pb[1]) + (pb[2] + pb[3])) * rs2 + RMS_EPS);
                    const int pos = hh ? (t & 63) : (t >> 6);
                    const f32x4 c = *(const f32x4*)(tcC + pos * 32 + i0), s = *(const f32x4*)(tsC + pos * 32 + i0);
                    bf16_t* rowp = dst + (size_t)t * ld + wc * 32 + 8 * fq;
#pragma unroll
                    for (int bj = 0; bj < 2; ++bj) { const float r = bj ? r1 : r0; const f32x4 a = acc[ai][bj][m][0] * r * g1, b = acc[ai][bj][m][1] * r * g2;
                        *(u32x4*)(rowp + bj * HALF) = pack8(a * c - b * s, b * c + a * s); }
                    }
        } else if (pn < 10) { plain(acc, row0, wc, fq, VA + (pn - 8) * 256, 512, rs8);
        } else if (pn < 18) {
            bf16_t* dst = pn < 14 ? QB + (pn - 10) * 256 : KB + (pn - 14) * 256; const float* gain = pn < 14 ? gbq : gbk;
            const float qs = pn < 14 ? 0.125f * 1.4426950408889634f : 1.0f;
            partials(acc, wr, wc, fr, fq); PG8_EPI_BAR();
            const bool rope = ((wc & 1) == 0) && (fq < 2);
            const int l1 = rope ? fq * 4 : (wc & 1) * 32 + fq * 8, l2 = rope ? 8 + fq * 4 : (wc & 1) * 32 + fq * 8 + 4;
            const f32x4 g1 = *(const f32x4*)(gain + l1), g2 = *(const f32x4*)(gain + l2);
            const int sub = (wc >> 1) * 2;
#pragma unroll
            for (int ai = 0; ai < 2; ++ai)
#pragma unroll
                for (int m = 0; m < 4; ++m) { const int rl = ai * HALF + wr * 64 + m * 16 + fr, t = u.pm * BM + rl;
                    const float rs = rs8[ai][m], rs2 = rs * rs * (1.0f / 64.0f);
                    const float r0 = qs * rs * rsqrtf((P[rl * 8 + sub] + P[rl * 8 + sub + 1]) * rs2 + RMS_EPS), r1 = qs * rs * rsqrtf((P[rl * 8 + 4 + sub] + P[rl * 8 + 4 + sub + 1]) * rs2 + RMS_EPS);
                    f32x4 c = (f32x4){1.f, 1.f, 1.f, 1.f}, s = (f32x4){0.f, 0.f, 0.f, 0.f};
                    if (rope) { c = *(const f32x4*)(tcB + t * 8 + fq * 4); s = *(const f32x4*)(tsB + t * 8 + fq * 4); }
                    bf16_t* rowp = dst + (size_t)t * 1024 + wc * 32 + 8 * fq;
#pragma unroll
                    for (int bj = 0; bj < 2; ++bj) { const float r = bj ? r1 : r0; const f32x4 a = acc[ai][bj][m][0] * r * g1, b = acc[ai][bj][m][1] * r * g2;
                        *(u32x4*)(rowp + bj * HALF) = pack8(a * c - b * s, b * c + a * s); }
                    }
        } else if (pn < 22) { plain(acc, row0, wc, fq, VB + (pn - 18) * 256, 1024, rs8);
        } else if (pn < 26) { plain(acc, row0, wc, fq, CQL + (pn - 22) * 256, 1024, rs8); row_ssq(acc, row0, fq, SSQ_Q, true, rs8);
        } else if (pn < 28) { plain(acc, row0, wc, fq, CKVL + (pn - 26) * 256, 512, rs8); row_ssq(acc, row0, fq, SSQ_KV, true, rs8);
        } else {
            if (wc < 2) {
#pragma unroll
                for (int ai = 0; ai < 2; ++ai)
#pragma unroll
                    for (int m = 0; m < 4; ++m) { const int t = row0 + ai * HALF + m * 16; const float rs = rs8[ai][m]; float* rowp = CKR + (size_t)t * 64 + wc * 32 + 8 * fq;
                        *(f32x4*)rowp = acc[ai][0][m][0] * rs; *(f32x4*)(rowp + 4) = acc[ai][0][m][1] * rs; }
                row_ssq(acc, row0, fq, SSQ_KR, false, rs8);
            }
        }
    }
};

struct EpiQUp {
    static constexpr bool PERM = true, AFTER_DRAIN = false;
    bf16_t* QC; const float* SSQ_Q; const float* gq; const float *tcC, *tsC; PG8_LAS float* P;
    __device__ __forceinline__ void operator()(const f32x4 (&acc)[2][2][4][2], const Unit& u, int wr, int wc, int fr_, int fq_) const {
        int fr = fr_, fq = fq_; asm volatile("" : "+v"(fr), "+v"(fq));
#pragma unroll
        for (int ai = 0; ai < 2; ++ai)
#pragma unroll
            for (int m = 0; m < 4; ++m)
#pragma unroll
                for (int bj = 0; bj < 2; ++bj) { float s = dot4(acc[ai][bj][m][0]) + dot4(acc[ai][bj][m][1]); s = fq_sum(s);
                    if (fq == 0) P[(ai * HALF + wr * 64 + m * 16 + fr) * 8 + bj * 4 + wc] = s; }
        PG8_EPI_BAR();
        const int h = u.pn, cn = wc * 32 + 8 * fq, i0 = (wc & 1) * 16 + fq * 4;
        const f32x4 gn1 = *(const f32x4*)(gq + cn), gn2 = *(const f32x4*)(gq + cn + 4);
        const f32x4 gr1 = *(const f32x4*)(gq + 128 + i0), gr2 = *(const f32x4*)(gq + 160 + i0);
#pragma unroll
        for (int ai = 0; ai < 2; ++ai)
#pragma unroll
            for (int m = 0; m < 4; ++m) { const int rl = ai * HALF + wr * 64 + m * 16 + fr, t = u.pm * BM + rl;
                const f32x4 pa = *(const PG8_LAS f32x4*)(P + rl * 8); const float pb0 = P[rl * 8 + 4], pb1 = P[rl * 8 + 5];
                const float rs = rsqrtf(SSQ_Q[t] * (1.0f / 1024.0f) + RMS_EPS);
                const float tot = (((pa[0] + pa[1]) + (pa[2] + pa[3])) + (pb0 + pb1)) * rs * rs;
                const float f = rs * rsqrtf(tot * (1.0f / 192.0f) + RMS_EPS) * (0.072168783648703220f * 1.4426950408889634f);
                bf16_t* rowp = QC + (size_t)t * 2304 + h * 192;
                *(u32x4*)(rowp + cn) = pack8(acc[ai][0][m][0] * f * gn1, acc[ai][0][m][1] * f * gn2);
                if (wc < 2) { const f32x4 c = *(const f32x4*)(tcC + t * 32 + i0), s = *(const f32x4*)(tsC + t * 32 + i0);
                    const f32x4 a = acc[ai][1][m][0] * f * gr1, b = acc[ai][1][m][1] * f * gr2;
                    *(u32x4*)(rowp + 128 + cn) = pack8(a * c - b * s, b * c + a * s); }
                }
    }
};

struct EpiKVUp {
    static constexpr bool PERM = true, AFTER_DRAIN = false;
    bf16_t *KC, *VC; const float *SSQ_KV, *SSQ_KR, *CKR; const float* gk; const float *tcC, *tsC; PG8_LAS float* P;
    __device__ __forceinline__ void operator()(const f32x4 (&acc)[2][2][4][2], const Unit& u, int wr, int wc, int fr_, int fq_) const {
        int fr = fr_, fq = fq_; asm volatile("" : "+v"(fr), "+v"(fq));
#pragma unroll
        for (int ai = 0; ai < 2; ++ai)
#pragma unroll
            for (int m = 0; m < 4; ++m) { float s = dot4(acc[ai][0][m][0]) + dot4(acc[ai][0][m][1]); s = fq_sum(s);
                if (fq == 0) P[(ai * HALF + wr * 64 + m * 16 + fr) * 8 + wc] = s; }
        PG8_EPI_BAR();
        const int h = u.pn, cn = wc * 32 + 8 * fq;
        const f32x4 gn1 = *(const f32x4*)(gk + cn), gn2 = *(const f32x4*)(gk + cn + 4);
#pragma unroll
        for (int ai = 0; ai < 2; ++ai)
#pragma unroll
            for (int m = 0; m < 4; ++m) { const int rl = ai * HALF + wr * 64 + m * 16 + fr, t = u.pm * BM + rl;
                const f32x4 pa = *(const PG8_LAS f32x4*)(P + rl * 8);
                const float rs = rsqrtf(SSQ_KV[t] * (1.0f / 512.0f) + RMS_EPS);
                const float tot = ((pa[0] + pa[1]) + (pa[2] + pa[3])) * rs * rs + SSQ_KR[t];
                const float rk = rsqrtf(tot * (1.0f / 192.0f) + RMS_EPS), f = rs * rk;
                *(u32x4*)(KC + (size_t)t * 2304 + h * 192 + cn) = pack8(acc[ai][0][m][0] * f * gn1, acc[ai][0][m][1] * f * gn2);
                *(u32x4*)(VC + (size_t)t * 1536 + h * 128 + cn) = pack8(acc[ai][1][m][0] * rs, acc[ai][1][m][1] * rs);
                if (wc == 0 && fq == 0) P[2048 + rl] = rk;
                }
        PG8_EPI_BAR();
        const int tid = (wr * 4 + wc) * 64 + fresh_lane();
#pragma unroll
        for (int k = 0; k < 4; ++k) { const int id = tid + 512 * k, rl = id >> 3, c8 = id & 7, i0 = (c8 >> 2) * 16 + (c8 & 3) * 4, t = u.pm * BM + rl;
            const float rk = P[2048 + rl];
            const f32x4 x1 = *(const f32x4*)(CKR + (size_t)t * 64 + i0), x2 = *(const f32x4*)(CKR + (size_t)t * 64 + 32 + i0);
            const f32x4 g1 = *(const f32x4*)(gk + 128 + i0), g2 = *(const f32x4*)(gk + 160 + i0);
            const f32x4 c = *(const f32x4*)(tcC + t * 32 + i0), s = *(const f32x4*)(tsC + t * 32 + i0);
            const f32x4 a = x1 * rk * g1, b = x2 * rk * g2;
            *(u32x4*)(KC + (size_t)t * 2304 + h * 192 + 128 + 8 * c8) = pack8(a * c - b * s, b * c + a * s);
            }
    }
};

struct EpiResid {
    static constexpr bool PERM = true, AFTER_DRAIN = false;
    bf16_t* hb; float* out; int ldc; float* ssq;
    __device__ __forceinline__ void operator()(const f32x4 (&acc)[2][2][4][2], const Unit& u, int wr, int wc, int fr_, int fq_) const {
        int fr = fr_, fq = fq_; asm volatile("" : "+v"(fr), "+v"(fq));
        const int col0 = u.pn * BM + wc * 32 + 8 * fq;
#pragma unroll
        for (int ai = 0; ai < 2; ++ai) { u32x4 hb8[4][2];
#pragma unroll
            for (int m = 0; m < 4; ++m)
#pragma unroll
                for (int bj = 0; bj < 2; ++bj) hb8[m][bj] = *(const u32x4*)(hb + (size_t)(u.pm * BM + ai * HALF + wr * 64 + m * 16 + fr) * ldc + col0 + bj * HALF);
            asm volatile("" : "+v"(hb8[0][0]), "+v"(hb8[0][1]), "+v"(hb8[1][0]), "+v"(hb8[1][1]), "+v"(hb8[2][0]), "+v"(hb8[2][1]), "+v"(hb8[3][0]), "+v"(hb8[3][1]));
#pragma unroll
            for (int m = 0; m < 4; ++m) { const size_t off = (size_t)(u.pm * BM + ai * HALF + wr * 64 + m * 16 + fr) * ldc + col0; float s = 0.f;
#pragma unroll
                for (int bj = 0; bj < 2; ++bj) { const u32x4 b = hb8[m][bj];
                    const f32x4 o0 = (f32x4){__uint_as_float(b.x << 16), __uint_as_float(b.x & 0xffff0000u), __uint_as_float(b.y << 16), __uint_as_float(b.y & 0xffff0000u)} + acc[ai][bj][m][0];
                    const f32x4 o1 = (f32x4){__uint_as_float(b.z << 16), __uint_as_float(b.z & 0xffff0000u), __uint_as_float(b.w << 16), __uint_as_float(b.w & 0xffff0000u)} + acc[ai][bj][m][1];
                    if (out) { *(f32x4*)(out + off + bj * HALF) = o0; *(f32x4*)(out + off + bj * HALF + 4) = o1; }
                    else { *(u32x4*)(hb + off + bj * HALF) = pack8(o0, o1); s += dot4(o0) + dot4(o1); } }
                if (!out) { s = fq_sum(s); if (fq == 0) __hip_atomic_fetch_add(ssq + u.pm * BM + ai * HALF + wr * 64 + m * 16 + fr, s, __ATOMIC_RELAXED, __HIP_MEMORY_SCOPE_AGENT); } } }
    }
};

struct EpiGateUp {
    static constexpr bool PERM = true, AFTER_DRAIN = false;
    bf16_t* ACT; int ldc; const float* SSQ_H;
    __device__ __forceinline__ void operator()(const f32x4 (&acc)[2][2][4][2], const Unit& u, int wr, int wc, int fr_, int fq_) const {
        int fr = fr_, fq = fq_; asm volatile("" : "+v"(fr), "+v"(fq));
        const int col0 = u.pn * HALF + wc * 32 + 8 * fq;
        float q8[2][4];
#pragma unroll
        for (int ai = 0; ai < 2; ++ai)
#pragma unroll
            for (int m = 0; m < 4; ++m) q8[ai][m] = SSQ_H[u.pm * BM + ai * HALF + wr * 64 + m * 16 + fr];
        asm volatile("" : "+v"(q8[0][0]), "+v"(q8[0][1]), "+v"(q8[0][2]), "+v"(q8[0][3]), "+v"(q8[1][0]), "+v"(q8[1][1]), "+v"(q8[1][2]), "+v"(q8[1][3]));
#pragma unroll
        for (int ai = 0; ai < 2; ++ai)
#pragma unroll
            for (int m = 0; m < 4; ++m) { f32x4 o[2]; const float rs = rsqrtf(q8[ai][m] * (1.0f / 4096.0f) + RMS_EPS);
#pragma unroll
                for (int n = 0; n < 2; ++n) { const f32x4 g = acc[ai][0][m][n] * rs, up = acc[ai][1][m][n] * rs;
#pragma unroll
                    for (int j = 0; j < 4; ++j) { const float e = __builtin_amdgcn_exp2f(g[j] * -1.4426950408889634f); o[n][j] = g[j] * __builtin_amdgcn_rcpf(1.0f + e) * up[j]; } }
                *(u32x4*)(ACT + (size_t)(u.pm * BM + ai * HALF + wr * 64 + m * 16 + fr) * ldc + col0) = pack8(o[0], o[1]); }
    }
};
}
namespace att {
typedef unsigned short bf16_t;
using bf16x8 = __attribute__((ext_vector_type(8))) short;
using s16x4  = __attribute__((ext_vector_type(4))) short;
using f32x16 = __attribute__((ext_vector_type(16))) float;
using u32x4  = __attribute__((ext_vector_type(4))) unsigned;
constexpr int NW = 8, QBLK = 32, KVBLK = 64;
constexpr int SHM_V = KVBLK * 128 * 2;
template <int NKS> struct KCfg { static constexpr int DQK = NKS * 16, KROW = DQK * 2 + 16, SHM_K = KVBLK * KROW, CPR = DQK / 8, NCH = DQK / 64; };
template <int NKS, int QL, int NSLOT = 2> constexpr int lds_bytes() { return NSLOT * SHM_V + NSLOT * KCfg<NKS>::SHM_K + NW * 64 * 4 + (QL ? NW * 32 * (QL * 32 + 16) : 0); }
#define SBAR() __builtin_amdgcn_sched_barrier(0)
typedef unsigned v4u32_t __attribute__((ext_vector_type(4)));
__device__ __forceinline__ __amdgpu_buffer_rsrc_t make_srd(const void* p, unsigned bytes) {
  const unsigned long long q = (unsigned long long)p;
  const unsigned lo = __builtin_amdgcn_readfirstlane((unsigned)q), hi = __builtin_amdgcn_readfirstlane((unsigned)(q >> 32));
  return __builtin_amdgcn_make_buffer_rsrc((void*)(((unsigned long long)hi << 32) | lo), (short)0, (int)bytes, 0x00020000);
}
__device__ __forceinline__ bf16x8 buf_ld16(__amdgpu_buffer_rsrc_t srd, unsigned voff, unsigned soff) {
  const v4u32_t v = __builtin_amdgcn_raw_buffer_load_b128(srd, (int)voff, (int)soff, 0); return __builtin_bit_cast(bf16x8, v);
}
__device__ __forceinline__ int crow(int r, int hi) { return (r & 3) + 8 * (r >> 2) + 4 * hi; }
__device__ __forceinline__ unsigned cvtpk(float lo, float hi) { unsigned r; asm volatile("v_cvt_pk_bf16_f32 %0, %1, %2" : "=v"(r) : "v"(lo), "v"(hi)); return r; }
#ifndef ATT_PROBE
#define ATT_PROBE 0
#endif
#ifndef ATT_HANDSCHED
#define ATT_HANDSCHED 1
#endif
constexpr bool HANDSCHED = ATT_HANDSCHED != 0;
constexpr float THR = 8.f, THRL = THR * 1.4426950408889634f;

__device__ __forceinline__ float max3f(float a, float b, float c) { float r; asm("v_max3_f32 %0, %1, %2, %3" : "=v"(r) : "v"(a), "v"(b), "v"(c)); return r; }
__device__ __forceinline__ float max2f(float a, float b) { float r; asm("v_max_f32_e32 %0, %1, %2" : "=v"(r) : "v"(a), "v"(b)); return r; }
template <bool BND = false> __device__ __forceinline__ void partialSM(f32x16& p0, f32x16& p1, float& m_ref, f32x16& negm, float& alpha, const float THRL) {
  if constexpr (BND) { alpha = 1.f;
#pragma unroll
    for (int r = 0; r < 16; ++r) p0[r] = __builtin_amdgcn_exp2f(p0[r]);
    return; }
  float a = max3f(p0[0], p0[1], p1[0]), b = max3f(p0[2], p0[3], p1[1]); a = max3f(a, p1[2], p1[3]);
#pragma unroll
  for (int r = 4; r < 16; r += 4) { a = max3f(a, p0[r], p0[r + 1]); b = max3f(b, p0[r + 2], p0[r + 3]); a = max3f(a, p1[r], p1[r + 1]); b = max3f(b, p1[r + 2], p1[r + 3]); }
  float rm = max2f(a, b);
  { auto rr = __builtin_amdgcn_permlane32_swap(__float_as_uint(rm), __float_as_uint(rm), false, false);
    rm = max2f(__uint_as_float(rr[0]), __uint_as_float(rr[1])); }
  alpha = 1.f;
  if (__builtin_expect(__any(rm > THRL), 0)) {
    const float dl = fmaxf(rm, 0.f);
#pragma unroll
    for (int r = 0; r < 16; ++r) { p0[r] -= dl; p1[r] -= dl; }
#pragma unroll
    for (int r = 0; r < 16; ++r) negm[r] -= dl;
    alpha = __builtin_amdgcn_exp2f(-dl);
  }
#pragma unroll
  for (int r = 0; r < 16; ++r) p0[r] = __builtin_amdgcn_exp2f(p0[r]);
}
template <bool EXP1 = true> __device__ __forceinline__ void finishSM(f32x16& p0, f32x16& p1, float alpha, float& l_reg, bf16x8& pa0, bf16x8& pa1, bf16x8& pa2, bf16x8& pa3) {
  if constexpr (EXP1) {
#pragma unroll
  for (int r = 0; r < 16; ++r) p1[r] = __builtin_amdgcn_exp2f(p1[r]); }
  float ps = 0;
  if (ATT_PROBE == 1) { float junk = 0.f;
#pragma unroll
    for (int r = 0; r < 16; ++r) { float t0 = p0[r], t1 = p1[r]; asm volatile("v_exp_f32 %0, %0\n\tv_exp_f32 %1, %1" : "+v"(t0), "+v"(t1)); junk += t0 + t1; }
    asm volatile("" :: "v"(junk)); }
#pragma unroll
  for (int r = 0; r < 16; ++r) ps += p0[r];
#pragma unroll
  for (int r = 0; r < 16; ++r) ps += p1[r];
  { auto rr = __builtin_amdgcn_permlane32_swap(__float_as_uint(ps), __float_as_uint(ps), false, false);
    ps = __uint_as_float(rr[0]) + __uint_as_float(rr[1]); }
  l_reg = l_reg * alpha + ps;
#define PK4(P, BASE, OUT) do { unsigned a0 = cvtpk(P[BASE + 0], P[BASE + 1]), a1 = cvtpk(P[BASE + 2], P[BASE + 3]);   \
    unsigned b0 = cvtpk(P[BASE + 4], P[BASE + 5]), b1 = cvtpk(P[BASE + 6], P[BASE + 7]);                              \
    u32x4 w = {a0, a1, b0, b1}; OUT = *reinterpret_cast<bf16x8*>(&w); } while (0)
  PK4(p0, 0, pa0); PK4(p0, 8, pa1); PK4(p1, 0, pa2); PK4(p1, 8, pa3);
#undef PK4
}
template <int NKS, int QL> __device__ __forceinline__ void qkt(f32x16& p0, f32x16& p1, const char* Ks, const bf16x8* qr, const char* ql, const f32x16& negm, int r32, int hi) {
  constexpr int KROW = KCfg<NKS>::KROW;
#pragma unroll
  for (int d0 = 0; d0 < NKS; ++d0) { const int cb = (d0 * 16 + hi * 8) * 2;
    const bf16x8 b0 = *reinterpret_cast<const bf16x8*>(Ks + r32 * KROW + cb);
    const bf16x8 b1 = *reinterpret_cast<const bf16x8*>(Ks + (32 + r32) * KROW + cb);
    if (ATT_PROBE == 2) { bf16x8 x0 = *reinterpret_cast<const volatile bf16x8*>(Ks + r32 * KROW + cb), x1 = *reinterpret_cast<const volatile bf16x8*>(Ks + (32 + r32) * KROW + cb); asm volatile("" :: "v"(x0), "v"(x1)); }
    bf16x8 q; if constexpr (QL > 0) { if (d0 >= NKS - QL) q = *reinterpret_cast<const bf16x8*>(ql + (d0 - (NKS - QL)) * 32); else q = qr[d0]; } else q = qr[d0];
    if (d0 == 0) { p0 = __builtin_amdgcn_mfma_f32_32x32x16_bf16(b0, q, negm, 0, 0, 0); p1 = __builtin_amdgcn_mfma_f32_32x32x16_bf16(b1, q, negm, 0, 0, 0); }
    else { p0 = __builtin_amdgcn_mfma_f32_32x32x16_bf16(b0, q, p0, 0, 0, 0); p1 = __builtin_amdgcn_mfma_f32_32x32x16_bf16(b1, q, p1, 0, 0, 0); } }
}
__device__ __forceinline__ int v_st(int k, int c) { const int kk = k; return ((kk >> 3) * 4 + (c >> 5)) * 512 + ((kk & 7) * 32 + (c & 31)) * 2; }
__device__ __forceinline__ int v_rd_base(int lane) { return ((lane & 3) << 3) | (((lane >> 2) & 3) << 6) | (((lane >> 4) & 1) << 5) | (((lane >> 5) & 1) << 8); }
constexpr int v_rd_off(int d0, int ks, int half) { return d0 * 512 + ks * 4096 + half * 2048; }
typedef short v4i16_t __attribute__((ext_vector_type(4)));
template <int OFF> __device__ __forceinline__ s16x4 tr_read(int vb) {
  return __builtin_bit_cast(s16x4, __builtin_amdgcn_ds_read_tr16_b64_v4i16((__attribute__((address_space(3))) v4i16_t*)(uintptr_t)(unsigned)(vb + OFF)));
}
struct VFrag { s16x4 l0, h0, l1, h1, l2, h2, l3, h3; };
template <int D0> __device__ __forceinline__ void v_read8(VFrag& f, int vb) {
  f.l0 = tr_read<v_rd_off(D0, 0, 0)>(vb); f.h0 = tr_read<v_rd_off(D0, 0, 1)>(vb); f.l1 = tr_read<v_rd_off(D0, 1, 0)>(vb); f.h1 = tr_read<v_rd_off(D0, 1, 1)>(vb);
  f.l2 = tr_read<v_rd_off(D0, 2, 0)>(vb); f.h2 = tr_read<v_rd_off(D0, 2, 1)>(vb); f.l3 = tr_read<v_rd_off(D0, 3, 0)>(vb); f.h3 = tr_read<v_rd_off(D0, 3, 1)>(vb);
}
__device__ __forceinline__ void pv_mma4(f32x16& od, const VFrag& f, bf16x8 pa0, bf16x8 pa1, bf16x8 pa2, bf16x8 pa3) {
#define PK(L, H) (bf16x8){L[0], L[1], L[2], L[3], H[0], H[1], H[2], H[3]}
  od = __builtin_amdgcn_mfma_f32_32x32x16_bf16(pa0, PK(f.l0, f.h0), od, 0, 0, 0);
  od = __builtin_amdgcn_mfma_f32_32x32x16_bf16(pa1, PK(f.l1, f.h1), od, 0, 0, 0);
  od = __builtin_amdgcn_mfma_f32_32x32x16_bf16(pa2, PK(f.l2, f.h2), od, 0, 0, 0);
  od = __builtin_amdgcn_mfma_f32_32x32x16_bf16(pa3, PK(f.l3, f.h3), od, 0, 0, 0);
#undef PK
}
#define PV_WAIT(N) SBAR()
__device__ __forceinline__ void pv_d0(f32x16* o, int vb, bf16x8 pa0, bf16x8 pa1, bf16x8 pa2, bf16x8 pa3) {
  VFrag fa, fb;
  SBAR(); v_read8<0>(fa, vb); v_read8<1>(fb, vb); PV_WAIT(8);
  pv_mma4(o[0], fa, pa0, pa1, pa2, pa3); SBAR();
  v_read8<2>(fa, vb); PV_WAIT(8);
  pv_mma4(o[1], fb, pa0, pa1, pa2, pa3); SBAR();
  v_read8<3>(fb, vb); PV_WAIT(8);
  pv_mma4(o[2], fa, pa0, pa1, pa2, pa3); PV_WAIT(0);
  pv_mma4(o[3], fb, pa0, pa1, pa2, pa3);
}

#define MX3(a, b, c) __builtin_fmaxf(__builtin_fmaxf((a), (b)), (c))
template <int S> __device__ __forceinline__ void fin_slot(f32x16& p0, f32x16& p1, float& sacc, unsigned (&cv)[16], u32x4 (&w)[4]) {
  if constexpr (S < 16) sacc += p0[S];
  else if constexpr (S >= 28 && S < 44) sacc += p1[S - 28];
  else { constexpr bool second = S >= 44; constexpr int k = second ? S - 44 : S - 16, grp = k / 6, idx = k % 6, t = (second ? 2 : 0) + grp, cb = 4 * t;
    if constexpr (idx < 4) { constexpr int e = 2 * (grp * 4 + idx); cv[cb + idx] = second ? cvtpk(p1[e], p1[e + 1]) : cvtpk(p0[e], p0[e + 1]); }
    else if constexpr (idx == 4) { w[t].x = cv[cb]; w[t].y = cv[cb + 1]; }
    else { w[t].z = cv[cb + 2]; w[t].w = cv[cb + 3]; } }
}
template <int S0, int S1> __device__ __forceinline__ void fin_slots(f32x16& p0, f32x16& p1, float& sacc, unsigned (&cv)[16], u32x4 (&w)[4]) {
  if constexpr (S0 < S1) { fin_slot<S0>(p0, p1, sacc, cv, w); fin_slots<S0 + 1, S1>(p0, p1, sacc, cv, w); }
}
template <int NM, int G> constexpr int fin_bound() { return (56 * G) / NM; }
template <int NKS, int D0> __device__ __forceinline__ void r1_steps(f32x16& X0, f32x16& X1, const char* kp, const bf16x8* qr, const f32x16& negm, f32x16& Y0, f32x16& Y1, float& sacc,
                                                                   unsigned (&cv)[16], u32x4 (&w)[4], bf16x8& ka0, bf16x8& ka1, bf16x8& kb0, bf16x8& kb1) {
  if constexpr (D0 < NKS) { constexpr int KROW = KCfg<NKS>::KROW, NM = 2 * NKS;
    bf16x8& k0 = (D0 & 1) ? kb0 : ka0; bf16x8& k1 = (D0 & 1) ? kb1 : ka1;
    if constexpr (D0 == 0) X0 = __builtin_amdgcn_mfma_f32_32x32x16_bf16(k0, qr[D0], negm, 0, 0, 0); else X0 = __builtin_amdgcn_mfma_f32_32x32x16_bf16(k0, qr[D0], X0, 0, 0, 0);
    if constexpr (ATT_PROBE == 4 && NKS == 4) { f32x16 dm_ = negm; dm_ = __builtin_amdgcn_mfma_f32_32x32x16_bf16(k1, qr[D0], dm_, 0, 0, 0); asm volatile("" :: "v"(dm_)); }
    if constexpr (ATT_PROBE == 5 && NKS == 4) { bf16x8 x0_ = *reinterpret_cast<const volatile bf16x8*>(kp + D0 * 32), x1_ = *reinterpret_cast<const volatile bf16x8*>(kp + 32 * KROW + D0 * 32); asm volatile("" :: "v"(x0_), "v"(x1_)); }
    fin_slots<fin_bound<NM, 2 * D0>(), fin_bound<NM, 2 * D0 + 1>()>(Y0, Y1, sacc, cv, w);
    if (ATT_PROBE == 3) { float t_ = sacc; asm volatile("v_exp_f32 %0, %0" : "+v"(t_)); asm volatile("" :: "v"(t_)); }
    SBAR();
    if constexpr (D0 == 0) X1 = __builtin_amdgcn_mfma_f32_32x32x16_bf16(k1, qr[D0], negm, 0, 0, 0); else X1 = __builtin_amdgcn_mfma_f32_32x32x16_bf16(k1, qr[D0], X1, 0, 0, 0);
    if constexpr (D0 + 2 < NKS) { k0 = *reinterpret_cast<const bf16x8*>(kp + (D0 + 2) * 32); k1 = *reinterpret_cast<const bf16x8*>(kp + 32 * KROW + (D0 + 2) * 32); }
    fin_slots<fin_bound<NM, 2 * D0 + 1>(), fin_bound<NM, 2 * D0 + 2>()>(Y0, Y1, sacc, cv, w);
    if (ATT_PROBE == 3) { float t_ = sacc; asm volatile("v_exp_f32 %0, %0" : "+v"(t_)); asm volatile("" :: "v"(t_)); }
    SBAR();
    r1_steps<NKS, D0 + 1>(X0, X1, kp, qr, negm, Y0, Y1, sacc, cv, w, ka0, ka1, kb0, kb1); }
}
template <int NKS> __device__ __forceinline__ void region1(f32x16& X0, f32x16& X1, const char* Ks, const bf16x8* qr, const f32x16& negm, f32x16& Y0, f32x16& Y1, float alY, float& l_reg,
                                                          bf16x8& pa0, bf16x8& pa1, bf16x8& pa2, bf16x8& pa3, int r32, int hi) {
  constexpr int KROW = KCfg<NKS>::KROW;
  const char* kp = Ks + r32 * KROW + hi * 16;
  bf16x8 ka0 = *reinterpret_cast<const bf16x8*>(kp), ka1 = *reinterpret_cast<const bf16x8*>(kp + 32 * KROW), kb0 = *reinterpret_cast<const bf16x8*>(kp + 32), kb1 = *reinterpret_cast<const bf16x8*>(kp + 32 * KROW + 32);
  float sacc = 0.f; unsigned cv[16]; u32x4 w[4]; SBAR();
  r1_steps<NKS, 0>(X0, X1, kp, qr, negm, Y0, Y1, sacc, cv, w, ka0, ka1, kb0, kb1);
  { auto rr = __builtin_amdgcn_permlane32_swap(__float_as_uint(sacc), __float_as_uint(sacc), false, false); sacc = __uint_as_float(rr[0]) + __uint_as_float(rr[1]); }
  l_reg = l_reg * alY + sacc;
  pa0 = *reinterpret_cast<bf16x8*>(&w[0]); pa1 = *reinterpret_cast<bf16x8*>(&w[1]); pa2 = *reinterpret_cast<bf16x8*>(&w[2]); pa3 = *reinterpret_cast<bf16x8*>(&w[3]);
}
#define PVM(OD, PA, L, H) OD = __builtin_amdgcn_mfma_f32_32x32x16_bf16(PA, ((bf16x8){L[0], L[1], L[2], L[3], H[0], H[1], H[2], H[3]}), OD, 0, 0, 0)
template <bool BND = false> __device__ __forceinline__ void region2(f32x16* o, int vb, bf16x8 pa0, bf16x8 pa1, bf16x8 pa2, bf16x8 pa3, f32x16& X0, f32x16& X1, float& m_ref, f32x16& negm, float& alpha, const float THRL) {
  if constexpr (BND) {
    VFrag fb; alpha = 1.f;
#define EX1(i) X0[i] = __builtin_amdgcn_exp2f(X0[i]); X1[i] = __builtin_amdgcn_exp2f(X1[i]); asm volatile("" : "+v"(X0), "+v"(X1))
    SBAR(); v_read8<0>(fb, vb); SBAR();
    PVM(o[0], pa0, fb.l0, fb.h0); EX1(0); SBAR();
    PVM(o[0], pa1, fb.l1, fb.h1); EX1(1); SBAR();
    PVM(o[0], pa2, fb.l2, fb.h2); EX1(2); SBAR();
    PVM(o[0], pa3, fb.l3, fb.h3); EX1(3); SBAR();
    v_read8<1>(fb, vb); SBAR();
    PVM(o[1], pa0, fb.l0, fb.h0); EX1(4); SBAR();
    PVM(o[1], pa1, fb.l1, fb.h1); EX1(5); SBAR();
    PVM(o[1], pa2, fb.l2, fb.h2); EX1(6); SBAR();
    PVM(o[1], pa3, fb.l3, fb.h3); EX1(7); SBAR();
    v_read8<2>(fb, vb); SBAR();
    PVM(o[2], pa0, fb.l0, fb.h0); EX1(8); SBAR();
    PVM(o[2], pa1, fb.l1, fb.h1); EX1(9); SBAR();
    PVM(o[2], pa2, fb.l2, fb.h2); EX1(10); SBAR();
    PVM(o[2], pa3, fb.l3, fb.h3); EX1(11); SBAR();
    v_read8<3>(fb, vb); SBAR();
    PVM(o[3], pa0, fb.l0, fb.h0); EX1(12); SBAR();
    PVM(o[3], pa1, fb.l1, fb.h1); EX1(13); SBAR();
    PVM(o[3], pa2, fb.l2, fb.h2); EX1(14); SBAR();
    PVM(o[3], pa3, fb.l3, fb.h3); EX1(15); SBAR();
#undef EX1
    return; }
  VFrag fa; float a, b;
  SBAR(); v_read8<0>(fa, vb); SBAR();
  PVM(o[0], pa0, fa.l0, fa.h0); a = MX3(X0[0], X0[1], X1[0]); b = MX3(X0[2], X0[3], X1[1]); SBAR();
  PVM(o[0], pa1, fa.l1, fa.h1); a = MX3(a, X1[2], X1[3]); a = MX3(a, X0[4], X0[5]); SBAR();
  PVM(o[0], pa2, fa.l2, fa.h2); b = MX3(b, X0[6], X0[7]); a = MX3(a, X1[4], X1[5]); SBAR();
  PVM(o[0], pa3, fa.l3, fa.h3); b = MX3(b, X1[6], X1[7]); a = MX3(a, X0[8], X0[9]); SBAR();
  v_read8<1>(fa, vb); SBAR();
  PVM(o[1], pa0, fa.l0, fa.h0); b = MX3(b, X0[10], X0[11]); a = MX3(a, X1[8], X1[9]); SBAR();
  PVM(o[1], pa1, fa.l1, fa.h1); b = MX3(b, X1[10], X1[11]); a = MX3(a, X0[12], X0[13]); SBAR();
  PVM(o[1], pa2, fa.l2, fa.h2); b = MX3(b, X0[14], X0[15]); a = MX3(a, X1[12], X1[13]); SBAR();
  PVM(o[1], pa3, fa.l3, fa.h3); b = MX3(b, X1[14], X1[15]); float rm = __builtin_fmaxf(a, b);
  { auto rr = __builtin_amdgcn_permlane32_swap(__float_as_uint(rm), __float_as_uint(rm), false, false); rm = __builtin_fmaxf(__uint_as_float(rr[0]), __uint_as_float(rr[1])); }
  SBAR(); v_read8<2>(fa, vb); SBAR();
  alpha = 1.f;
  if (__builtin_expect(__any(rm > THRL), 0)) {
    const float dl = fmaxf(rm, 0.f);
#pragma unroll
    for (int r = 0; r < 16; ++r) { X0[r] -= dl; X1[r] -= dl; }
#pragma unroll
    for (int r = 0; r < 16; ++r) negm[r] -= dl;
    alpha = __builtin_amdgcn_exp2f(-dl);
  }
  SBAR();
#define EX2(i) X0[i] = __builtin_amdgcn_exp2f(X0[i]); X0[i + 1] = __builtin_amdgcn_exp2f(X0[i + 1]); X1[i] = __builtin_amdgcn_exp2f(X1[i]); X1[i + 1] = __builtin_amdgcn_exp2f(X1[i + 1]); asm volatile("" : "+v"(X0), "+v"(X1))
  PVM(o[2], pa0, fa.l0, fa.h0); EX2(0); SBAR();
  PVM(o[2], pa1, fa.l1, fa.h1); EX2(2); SBAR();
  PVM(o[2], pa2, fa.l2, fa.h2); EX2(4); SBAR();
  PVM(o[2], pa3, fa.l3, fa.h3); EX2(6); SBAR();
  v_read8<3>(fa, vb); SBAR();
  PVM(o[3], pa0, fa.l0, fa.h0); EX2(8); SBAR();
  PVM(o[3], pa1, fa.l1, fa.h1); EX2(10); SBAR();
  PVM(o[3], pa2, fa.l2, fa.h2); EX2(12); SBAR();
  PVM(o[3], pa3, fa.l3, fa.h3); EX2(14); SBAR();
#undef EX2
}
#undef PVM

template <int NKS, int SD, int QL, bool DBL, int NSLOT, int ldq, int ldk, int ldv, bool BND = false>
__device__ __forceinline__ void attn_pass(const bf16_t* __restrict__ Qb, const bf16_t* __restrict__ Kh, const bf16_t* __restrict__ Vh,
                                          const int seq, char* lds, const float THRL, f32x16 (&o)[4], const int wave_) {
  using KC = KCfg<NKS>; constexpr int KROW = KC::KROW, SHM_K = KC::SHM_K, CPR = KC::CPR, NCH = KC::NCH;
  int wv_ = wave_; asm volatile("" : "+s"(wv_));
  const int lane = fresh_lane(), wid = wv_, tid = wid * 64 + lane, r32 = lane & 31, hi = lane >> 5;
  char* V_lds = lds; char* K_lds = lds + NSLOT * SHM_V;
  float* ws = (float*)(lds + NSLOT * SHM_V + NSLOT * SHM_K) + wid * 64; float* li_l = ws; float* al_l = ws + 32;
  float m_reg = 0.f, l_reg = 0; bf16x8 qr[NKS - QL]; f32x16 negm = f32x16{}; if constexpr (!BND) asm volatile("" : "+v"(negm));
  constexpr int QROW = QL * 32 + 16; char* ql = lds + NSLOT * SHM_V + NSLOT * SHM_K + NW * 64 * 4 + wid * (32 * QROW) + r32 * QROW + hi * 16;
#pragma unroll
  for (int d = 0; d < 4; ++d) o[d] = f32x16{};
  const bf16_t* Qw = Qb + (long)(wid * QBLK + r32) * ldq + hi * 8;
#pragma unroll
  for (int d0 = 0; d0 < NKS; ++d0) { const bf16x8 qv = *reinterpret_cast<const bf16x8*>(Qw + d0 * 16); if (d0 < NKS - QL) qr[d0 < NKS - QL ? d0 : 0] = qv; else *reinterpret_cast<bf16x8*>(ql + (d0 - (NKS - QL)) * 32) = qv; }
  const int sr = tid >> 4, sc = (tid & 15) * 8, vst0 = v_st(sr, sc), vst1 = v_st(32 + sr, sc);
  const unsigned vgo0 = (unsigned)(sr * ldv + sc) * 2u, vgo1 = (unsigned)((32 + sr) * ldv + sc) * 2u;
  unsigned kgo[NCH]; int klo[NCH];
#pragma unroll
  for (int i = 0; i < NCH; ++i) { const int id = tid + 512 * i, row = id / CPR, ch = id % CPR; kgo[i] = (unsigned)(row * ldk + ch * 8) * 2u; klo[i] = row * KROW + ch * 16; }
  const __amdgpu_buffer_rsrc_t srdK = make_srd(Kh, (unsigned)seq * (unsigned)(ldk * 2)), srdV = make_srd(Vh, (unsigned)seq * (unsigned)(ldv * 2));
  const int vb0 = (int)(uintptr_t)V_lds + v_rd_base(lane);
  struct { bf16x8 vs0, vs1, ks[NCH]; } sr_[SD];
#define SLOAD(i, k0) do { const unsigned vso_ = (unsigned)(k0) * (unsigned)(ldv * 2), kso_ = (unsigned)(k0) * (unsigned)(ldk * 2); \
    sr_[i].vs0 = buf_ld16(srdV, vgo0, vso_); sr_[i].vs1 = buf_ld16(srdV, vgo1, vso_); \
    _Pragma("unroll") for (int c_ = 0; c_ < NCH; ++c_) sr_[i].ks[c_] = buf_ld16(srdK, kgo[c_], kso_); } while (0)
#define SWRITE(b, i) do { *(bf16x8*)(V_lds + (b) * SHM_V + vst0) = sr_[i].vs0; *(bf16x8*)(V_lds + (b) * SHM_V + vst1) = sr_[i].vs1; \
    _Pragma("unroll") for (int c_ = 0; c_ < NCH; ++c_) *(bf16x8*)(K_lds + (b) * SHM_K + klo[c_]) = sr_[i].ks[c_]; } while (0)
#define SWAIT() do { if constexpr (SD == 2) { if constexpr (NCH == 1) asm volatile("s_waitcnt vmcnt(3)" ::: "memory"); else if constexpr (NCH == 2) asm volatile("s_waitcnt vmcnt(4)" ::: "memory"); else asm volatile("s_waitcnt vmcnt(5)" ::: "memory"); } \
    else asm volatile("s_waitcnt vmcnt(0)" ::: "memory"); } while (0)
#define RESC(a) do { if constexpr (!BND) if (__any((a) < 1.f)) { if (hi == 0) al_l[r32] = (a); asm volatile("s_waitcnt lgkmcnt(0)" ::: "memory"); \
    _Pragma("unroll") for (int d = 0; d < 4; ++d) _Pragma("unroll") for (int r = 0; r < 16; ++r) o[d][r] *= al_l[crow(r, hi)]; } } while (0)
  const int NT = seq / KVBLK; constexpr int SE = 0, SO = SD - 1;
  if constexpr (!DBL) {
    static_assert(SD == 1, "single-state loop stages one tile ahead");
    f32x16 p0, p1; float mn, al; bf16x8 pa0, pa1, pa2, pa3;
    SLOAD(0, 0); asm volatile("s_waitcnt vmcnt(0)" ::: "memory"); SWRITE(0, 0); __syncthreads();
    for (int j = 0; j < NT; j += 2) {
      SLOAD(0, (j + 1) * KVBLK); SBAR();
      qkt<NKS, QL>(p0, p1, K_lds, qr, ql, negm, r32, hi); partialSM<BND>(p0, p1, m_reg, negm, al, THRL); RESC(al);
      finishSM(p0, p1, al, l_reg, pa0, pa1, pa2, pa3); SBAR();
      pv_d0(o, vb0, pa0, pa1, pa2, pa3);
      SWAIT(); SWRITE(1, 0); __syncthreads();
      if (j + 2 < NT) SLOAD(0, (j + 2) * KVBLK); SBAR();
      qkt<NKS, QL>(p0, p1, K_lds + SHM_K, qr, ql, negm, r32, hi); partialSM<BND>(p0, p1, m_reg, negm, al, THRL); RESC(al);
      finishSM(p0, p1, al, l_reg, pa0, pa1, pa2, pa3); SBAR();
      pv_d0(o, vb0 + SHM_V, pa0, pa1, pa2, pa3);
      if (j + 2 < NT) { SWAIT(); SWRITE(0, 0); } __syncthreads();
    }
  } else if constexpr (NSLOT == 3) {
    static_assert(SD == 1, "ring loop stages one tile ahead");
    f32x16 pA0, pA1, pB0, pB1; float alA, alB; bf16x8 pa0, pa1, pa2, pa3;
    SLOAD(0, 0); asm volatile("s_waitcnt vmcnt(0)" ::: "memory"); SWRITE(0, 0); __syncthreads();
    SLOAD(0, KVBLK);
    constexpr bool HS = HANDSCHED && QL == 0 && (NKS == 4 || NKS == 8);
    qkt<NKS, QL>(pA0, pA1, K_lds, qr, ql, negm, r32, hi); partialSM<BND>(pA0, pA1, m_reg, negm, alA, THRL);
    if constexpr (HS) {
#pragma unroll
      for (int r = 0; r < 16; ++r) pA1[r] = __builtin_amdgcn_exp2f(pA1[r]); }
    SWAIT(); SWRITE(1, 0); __syncthreads();
    int sp = 0, scur = 1, sn = 2;
#define RSTEP(PX0, PX1, ALX, PY0, PY1, ALY, TJ) do { \
      SLOAD(0, ((TJ) + 1) * KVBLK); SBAR(); \
      if constexpr (HS) { \
        region1<NKS>(PX0, PX1, K_lds + scur * SHM_K, qr, negm, PY0, PY1, ALY, l_reg, pa0, pa1, pa2, pa3, r32, hi); \
        region2<BND>(o, vb0 + sp * SHM_V, pa0, pa1, pa2, pa3, PX0, PX1, m_reg, negm, ALX, THRL); \
      } else { \
      qkt<NKS, QL>(PX0, PX1, K_lds + scur * SHM_K, qr, ql, negm, r32, hi); \
      finishSM(PY0, PY1, ALY, l_reg, pa0, pa1, pa2, pa3); SBAR(); \
      pv_d0(o, vb0 + sp * SHM_V, pa0, pa1, pa2, pa3); partialSM<BND>(PX0, PX1, m_reg, negm, ALX, THRL); } \
      SWAIT(); SWRITE(sn, 0); RESC(ALX); __syncthreads(); \
      { const int t_ = sp; sp = scur; scur = sn; sn = t_; } } while (0)
    for (int j = 1; j + 1 < NT; j += 2) {
      RSTEP(pB0, pB1, alB, pA0, pA1, alA, j);
      RSTEP(pA0, pA1, alA, pB0, pB1, alB, j + 1);
    }
#undef RSTEP
    SBAR(); qkt<NKS, QL>(pB0, pB1, K_lds + scur * SHM_K, qr, ql, negm, r32, hi);
    finishSM<!HS>(pA0, pA1, alA, l_reg, pa0, pa1, pa2, pa3); SBAR();
    pv_d0(o, vb0 + sp * SHM_V, pa0, pa1, pa2, pa3); partialSM<BND>(pB0, pB1, m_reg, negm, alB, THRL);
    RESC(alB);
    finishSM(pB0, pB1, alB, l_reg, pa0, pa1, pa2, pa3); SBAR();
    pv_d0(o, vb0 + scur * SHM_V, pa0, pa1, pa2, pa3);
  } else {
  f32x16 pA0, pA1, pB0, pB1; float mnA, mnB, alA, alB; bf16x8 pa0, pa1, pa2, pa3;
  SLOAD(SE, 0); asm volatile("s_waitcnt vmcnt(0)" ::: "memory"); SWRITE(0, SE); __syncthreads();
  qkt<NKS, QL>(pA0, pA1, K_lds, qr, ql, negm, r32, hi); partialSM(pA0, pA1, m_reg, negm, alA, THRL);
  SLOAD(SO, KVBLK); if constexpr (SD == 2) { if (2 < NT) SLOAD(SE, 2 * KVBLK); }
  SWAIT(); SWRITE(1, SO); __syncthreads();
  for (int j = 1; j + 1 < NT; j += 2) {
    SBAR(); qkt<NKS, QL>(pB0, pB1, K_lds + SHM_K, qr, ql, negm, r32, hi);
    finishSM(pA0, pA1, alA, l_reg, pa0, pa1, pa2, pa3); SBAR();
    SLOAD(SO, (j + SD) * KVBLK); SBAR();
    pv_d0(o, vb0, pa0, pa1, pa2, pa3); partialSM(pB0, pB1, m_reg, negm, alB, THRL);
    __syncthreads(); SWAIT(); SWRITE(0, SE);
    RESC(alB); __syncthreads();
    SBAR(); qkt<NKS, QL>(pA0, pA1, K_lds, qr, ql, negm, r32, hi);
    finishSM(pB0, pB1, alB, l_reg, pa0, pa1, pa2, pa3); SBAR();
    if (SD == 1 || j + 3 < NT) SLOAD(SE, (j + 1 + SD) * KVBLK); SBAR();
    pv_d0(o, vb0 + SHM_V, pa0, pa1, pa2, pa3); partialSM(pA0, pA1, m_reg, negm, alA, THRL);
    __syncthreads(); SWAIT(); SWRITE(1, SO);
    RESC(alA); __syncthreads();
  }
  SBAR(); qkt<NKS, QL>(pB0, pB1, K_lds + SHM_K, qr, ql, negm, r32, hi);
  finishSM(pA0, pA1, alA, l_reg, pa0, pa1, pa2, pa3); SBAR();
  pv_d0(o, vb0, pa0, pa1, pa2, pa3); partialSM(pB0, pB1, m_reg, negm, alB, THRL);
  __syncthreads(); RESC(alB);
  finishSM(pB0, pB1, alB, l_reg, pa0, pa1, pa2, pa3); SBAR();
  pv_d0(o, vb0 + SHM_V, pa0, pa1, pa2, pa3);
  }
  if (hi == 0) li_l[r32] = l_reg; asm volatile("s_waitcnt lgkmcnt(0)" ::: "memory");
#pragma unroll
  for (int r = 0; r < 16; ++r) { const float rl = __builtin_amdgcn_rcpf(li_l[crow(r, hi)]);
#pragma unroll
    for (int d = 0; d < 4; ++d) o[d][r] *= rl; }
  __syncthreads();
#undef SLOAD
#undef SWRITE
#undef SWAIT
#undef RESC
}
namespace a16 {
#ifndef ATT16_HS
#define ATT16_HS 1
#endif
constexpr bool A16_HS = ATT16_HS != 0;
constexpr int VROW = 288, SHM_V16 = KVBLK * VROW;
template <int NS> struct Cfg { static constexpr int DQK = NS * 32, KROW = NS == 2 ? 160 : NS == 4 ? 288 : 416, SHM_K = KVBLK * KROW, CPR = DQK / 8, NCH = DQK / 64; static_assert(NS == 2 || NS == 4 || NS == 6, "QK dim 64, 128 or 192"); };
template <int NS> constexpr int NSLOT16 = NS == 6 ? 2 : 3;
template <int NS> constexpr int lds_bytes() { return NSLOT16<NS> * (SHM_V16 + Cfg<NS>::SHM_K) + NW * 64 * 4; }
typedef float f32x4 __attribute__((ext_vector_type(4)));
template <int OFF> __device__ __forceinline__ s16x4 trd(int vb) { return __builtin_bit_cast(s16x4, __builtin_amdgcn_ds_read_tr16_b64_v4i16((__attribute__((address_space(3))) v4i16_t*)(uintptr_t)(unsigned)(vb + OFF))); }
struct PState { f32x4 p[2][4]; };
template <int NS> __device__ __forceinline__ void qkt16(PState& X, const char* kbase, const bf16x8 (&qf)[2][NS]) {
  constexpr int KROW = Cfg<NS>::KROW;
#pragma unroll
  for (int kb = 0; kb < 4; ++kb)
#pragma unroll
    for (int s = 0; s < NS; ++s) { const bf16x8 kf = *reinterpret_cast<const bf16x8*>(kbase + kb * 16 * KROW + s * 64);
#pragma unroll
      for (int qg = 0; qg < 2; ++qg) X.p[qg][kb] = __builtin_amdgcn_mfma_f32_16x16x32_bf16(kf, qf[qg][s], s == 0 ? (f32x4){0.f, 0.f, 0.f, 0.f} : X.p[qg][kb], 0, 0, 0); }
}
__device__ __forceinline__ void exp16(PState& X) {
#pragma unroll
  for (int qg = 0; qg < 2; ++qg)
#pragma unroll
    for (int kb = 0; kb < 4; ++kb)
#pragma unroll
      for (int r = 0; r < 4; ++r) X.p[qg][kb][r] = __builtin_amdgcn_exp2f(X.p[qg][kb][r]);
}
__device__ __forceinline__ void finish16(const PState& Y, float (&l)[8], bf16x8 (&pa)[2][2]) {
#pragma unroll
  for (int qg = 0; qg < 2; ++qg) { float s = 0.f;
#pragma unroll
    for (int kb = 0; kb < 4; ++kb) s += (Y.p[qg][kb][0] + Y.p[qg][kb][1]) + (Y.p[qg][kb][2] + Y.p[qg][kb][3]);
    l[4 * qg] += s;
#pragma unroll
    for (int sp = 0; sp < 2; ++sp) { u32x4 w; w.x = cvtpk(Y.p[qg][2 * sp][0], Y.p[qg][2 * sp][1]); w.y = cvtpk(Y.p[qg][2 * sp][2], Y.p[qg][2 * sp][3]);
      w.z = cvtpk(Y.p[qg][2 * sp + 1][0], Y.p[qg][2 * sp + 1][1]); w.w = cvtpk(Y.p[qg][2 * sp + 1][2], Y.p[qg][2 * sp + 1][3]); pa[qg][sp] = *reinterpret_cast<bf16x8*>(&w); } }
}
template <int CB> __device__ __forceinline__ void pv_cb(f32x4 (&o)[2][8], int vb, const bf16x8 (&pa)[2][2]) {
  const s16x4 l0 = trd<0 * VROW + CB * 32>(vb), h0 = trd<16 * VROW + CB * 32>(vb), l1 = trd<32 * VROW + CB * 32>(vb), h1 = trd<48 * VROW + CB * 32>(vb);
  const bf16x8 v0 = (bf16x8){l0[0], l0[1], l0[2], l0[3], h0[0], h0[1], h0[2], h0[3]}, v1 = (bf16x8){l1[0], l1[1], l1[2], l1[3], h1[0], h1[1], h1[2], h1[3]};
  o[0][CB] = __builtin_amdgcn_mfma_f32_16x16x32_bf16(pa[0][0], v0, o[0][CB], 0, 0, 0); o[1][CB] = __builtin_amdgcn_mfma_f32_16x16x32_bf16(pa[1][0], v0, o[1][CB], 0, 0, 0);
  o[0][CB] = __builtin_amdgcn_mfma_f32_16x16x32_bf16(pa[0][1], v1, o[0][CB], 0, 0, 0); o[1][CB] = __builtin_amdgcn_mfma_f32_16x16x32_bf16(pa[1][1], v1, o[1][CB], 0, 0, 0);
}
__device__ __forceinline__ void pv16(f32x4 (&o)[2][8], int vb, const bf16x8 (&pa)[2][2]) {
  pv_cb<0>(o, vb, pa); pv_cb<1>(o, vb, pa); pv_cb<2>(o, vb, pa); pv_cb<3>(o, vb, pa); pv_cb<4>(o, vb, pa); pv_cb<5>(o, vb, pa); pv_cb<6>(o, vb, pa); pv_cb<7>(o, vb, pa);
}
template <int S> __device__ __forceinline__ void fin16_slot(const PState& Y, float (&l)[8], unsigned (&cw)[2][2][4]) {
  constexpr int qg = S / 24, u = S % 24;
  if constexpr (u < 16) { float x_ = Y.p[qg][u >> 2][u & 3]; asm("v_add_f32_e32 %0, %1, %0" : "+v"(l[4 * qg + (u & 3)]) : "v"(x_)); }
  else { constexpr int w = u - 16, sp = w >> 2, i = w & 3, kb = 2 * sp + (i >> 1), r0 = (i & 1) * 2; cw[qg][sp][i] = cvtpk(Y.p[qg][kb][r0], Y.p[qg][kb][r0 + 1]); }
}
template <int S0, int S1> __device__ __forceinline__ void fin16_slots(const PState& Y, float (&l)[8], unsigned (&cw)[2][2][4]) {
  if constexpr (S0 < S1) { fin16_slot<S0>(Y, l, cw); fin16_slots<S0 + 1, S1>(Y, l, cw); }
}
template <int NS, int T> __device__ __forceinline__ void r1_16(PState& X, const char* kbase, const bf16x8 (&qf)[2][NS], const PState& Y, float (&l)[8], unsigned (&cw)[2][2][4], bf16x8& k0, bf16x8& k1, bf16x8& k2) {
  if constexpr (T < 4 * NS) { constexpr int KROW = Cfg<NS>::KROW, NM = 8 * NS, kb = T / NS, s = T % NS;
    bf16x8& kc = (T % 3 == 0) ? k0 : (T % 3 == 1) ? k1 : k2;
    if constexpr (T + 2 < 4 * NS) { bf16x8& kn = ((T + 2) % 3 == 0) ? k0 : ((T + 2) % 3 == 1) ? k1 : k2; kn = *reinterpret_cast<const bf16x8*>(kbase + ((T + 2) / NS) * 16 * KROW + ((T + 2) % NS) * 64); }
    X.p[0][kb] = __builtin_amdgcn_mfma_f32_16x16x32_bf16(kc, qf[0][s], s == 0 ? (f32x4){0.f, 0.f, 0.f, 0.f} : X.p[0][kb], 0, 0, 0);
    fin16_slots<(48 * (2 * T)) / NM, (48 * (2 * T + 1)) / NM>(Y, l, cw); SBAR();
    X.p[1][kb] = __builtin_amdgcn_mfma_f32_16x16x32_bf16(kc, qf[1][s], s == 0 ? (f32x4){0.f, 0.f, 0.f, 0.f} : X.p[1][kb], 0, 0, 0);
    fin16_slots<(48 * (2 * T + 1)) / NM, (48 * (2 * T + 2)) / NM>(Y, l, cw); SBAR();
    r1_16<NS, T + 1>(X, kbase, qf, Y, l, cw, k0, k1, k2); }
}
template <int NS> __device__ __forceinline__ void region1_16(PState& X, const char* kbase, const bf16x8 (&qf)[2][NS], const PState& Y, float (&l)[8], bf16x8 (&pa)[2][2]) {
  constexpr int KROW = Cfg<NS>::KROW;
  bf16x8 k0 = *reinterpret_cast<const bf16x8*>(kbase), k1 = *reinterpret_cast<const bf16x8*>(kbase + (1 / NS) * 16 * KROW + (1 % NS) * 64), k2;
  unsigned cw[2][2][4]; SBAR();
  r1_16<NS, 0>(X, kbase, qf, Y, l, cw, k0, k1, k2);
#pragma unroll
  for (int qg = 0; qg < 2; ++qg)
#pragma unroll
    for (int sp = 0; sp < 2; ++sp) { u32x4 w = {cw[qg][sp][0], cw[qg][sp][1], cw[qg][sp][2], cw[qg][sp][3]}; pa[qg][sp] = *reinterpret_cast<bf16x8*>(&w); }
}
__device__ __forceinline__ void region2_16(f32x4 (&o)[2][8], int vb, const bf16x8 (&pa)[2][2], PState& X) {
  s16x4 a0, a1, a2, a3, b0, b1, b2, b3, c0, c1, c2, c3;
#define VRD(P, CB) P##0 = trd<0 * VROW + (CB) * 32>(vb); P##1 = trd<16 * VROW + (CB) * 32>(vb); P##2 = trd<32 * VROW + (CB) * 32>(vb); P##3 = trd<48 * VROW + (CB) * 32>(vb)
#define PK8(L, H) ((bf16x8){L[0], L[1], L[2], L[3], H[0], H[1], H[2], H[3]})
#define EXQ(CB, r) X.p[(CB) >> 2][(CB) & 3][r] = __builtin_amdgcn_exp2f(X.p[(CB) >> 2][(CB) & 3][r]); asm volatile("" : "+v"(X.p[(CB) >> 2][(CB) & 3]))
#define BLK(P, CB) \
  o[0][CB] = __builtin_amdgcn_mfma_f32_16x16x32_bf16(pa[0][0], PK8(P##0, P##1), o[0][CB], 0, 0, 0); EXQ(CB, 0); SBAR(); \
  o[1][CB] = __builtin_amdgcn_mfma_f32_16x16x32_bf16(pa[1][0], PK8(P##0, P##1), o[1][CB], 0, 0, 0); EXQ(CB, 1); SBAR(); \
  o[0][CB] = __builtin_amdgcn_mfma_f32_16x16x32_bf16(pa[0][1], PK8(P##2, P##3), o[0][CB], 0, 0, 0); EXQ(CB, 2); SBAR(); \
  o[1][CB] = __builtin_amdgcn_mfma_f32_16x16x32_bf16(pa[1][1], PK8(P##2, P##3), o[1][CB], 0, 0, 0); EXQ(CB, 3); SBAR()
  SBAR(); VRD(a, 0); SBAR();
  VRD(b, 1); SBAR(); BLK(a, 0);
  VRD(c, 2); SBAR(); BLK(b, 1);
  VRD(a, 3); SBAR(); BLK(c, 2);
  VRD(b, 4); SBAR(); BLK(a, 3);
  VRD(c, 5); SBAR(); BLK(b, 4);
  VRD(a, 6); SBAR(); BLK(c, 5);
  VRD(b, 7); SBAR(); BLK(a, 6);
  BLK(b, 7);
#undef VRD
#undef PK8
#undef EXQ
#undef BLK
}
template <int NS, int ldq, int ldk, int ldv>
__device__ __forceinline__ void attn_pass16(const bf16_t* __restrict__ Qb, const bf16_t* __restrict__ Kh, const bf16_t* __restrict__ Vh, const int seq, char* lds, f32x4 (&o)[2][8], const int wave_) {
  using KC = Cfg<NS>; constexpr int KROW = KC::KROW, SHM_K = KC::SHM_K, CPR = KC::CPR, NCH = KC::NCH;
  int wv_ = wave_; asm volatile("" : "+s"(wv_));
  const int lane = fresh_lane(), wid = wv_, tid = wid * 64 + lane, c = lane & 15, g = lane >> 4;
  constexpr int NSL = NSLOT16<NS>;
  char* V_lds = lds; char* K_lds = lds + NSL * SHM_V16;
  float* li_l = (float*)(lds + NSL * SHM_V16 + NSL * SHM_K) + wid * 64;
  float l[8] = {0.f, 0.f, 0.f, 0.f, 0.f, 0.f, 0.f, 0.f};
#pragma unroll
  for (int qg = 0; qg < 2; ++qg)
#pragma unroll
    for (int cb = 0; cb < 8; ++cb) o[qg][cb] = (f32x4){0.f, 0.f, 0.f, 0.f};
  bf16x8 qf[2][NS];
#pragma unroll
  for (int qg = 0; qg < 2; ++qg)
#pragma unroll
    for (int s = 0; s < NS; ++s) qf[qg][s] = *reinterpret_cast<const bf16x8*>(Qb + (long)(wid * QBLK + qg * 16 + c) * ldq + s * 32 + g * 8);
  const int sr = tid >> 4, sc = (tid & 15) * 8, vst0 = sr * VROW + sc * 2, vst1 = (32 + sr) * VROW + sc * 2;
  const unsigned vgo0 = (unsigned)(sr * ldv + sc) * 2u, vgo1 = (unsigned)((32 + sr) * ldv + sc) * 2u;
  unsigned kgo[NCH]; int klo[NCH];
#pragma unroll
  for (int i = 0; i < NCH; ++i) { const int id = tid + 512 * i, row = id / CPR, ch = id % CPR; kgo[i] = (unsigned)(row * ldk + ch * 8) * 2u; klo[i] = row * KROW + ch * 16; }
  const int vb0 = (int)(uintptr_t)V_lds + (4 * g + (c >> 2)) * VROW + (c & 3) * 8;
  const int koff = c * KROW + g * 16;
  bf16x8 vs0, vs1, ks[NCH];
  const __amdgpu_buffer_rsrc_t srdK = make_srd(Kh, (unsigned)seq * (unsigned)(ldk * 2)), srdV = make_srd(Vh, (unsigned)seq * (unsigned)(ldv * 2));
#define SLOAD16(k0) do { const unsigned vso_ = (unsigned)(k0) * (unsigned)(ldv * 2), kso_ = (unsigned)(k0) * (unsigned)(ldk * 2); \
    vs0 = buf_ld16(srdV, vgo0, vso_); vs1 = buf_ld16(srdV, vgo1, vso_); \
    _Pragma("unroll") for (int c_ = 0; c_ < NCH; ++c_) ks[c_] = buf_ld16(srdK, kgo[c_], kso_); } while (0)
#define SWRITE16(b) do { *(bf16x8*)(V_lds + (b) * SHM_V16 + vst0) = vs0; *(bf16x8*)(V_lds + (b) * SHM_V16 + vst1) = vs1; \
    _Pragma("unroll") for (int c_ = 0; c_ < NCH; ++c_) *(bf16x8*)(K_lds + (b) * SHM_K + klo[c_]) = ks[c_]; } while (0)
  const int NT = seq / KVBLK;
  if constexpr (NSL == 2) {
    PState A; bf16x8 pa[2][2];
    SLOAD16(0); asm volatile("s_waitcnt vmcnt(0)" ::: "memory"); SWRITE16(0); __syncthreads();
    for (int j = 0; j < NT; j += 2) {
      SLOAD16((j + 1) * KVBLK); SBAR();
      qkt16<NS>(A, K_lds + koff, qf); exp16(A); finish16(A, l, pa); SBAR();
      pv16(o, vb0, pa);
      asm volatile("s_waitcnt vmcnt(0)" ::: "memory"); SWRITE16(1); __syncthreads();
      if (j + 2 < NT) SLOAD16((j + 2) * KVBLK); SBAR();
      qkt16<NS>(A, K_lds + SHM_K + koff, qf); exp16(A); finish16(A, l, pa); SBAR();
      pv16(o, vb0 + SHM_V16, pa);
      if (j + 2 < NT) { asm volatile("s_waitcnt vmcnt(0)" ::: "memory"); SWRITE16(0); } __syncthreads();
    }
  } else {
  PState A, B; bf16x8 pa[2][2];
  SLOAD16(0); asm volatile("s_waitcnt vmcnt(0)" ::: "memory"); SWRITE16(0); __syncthreads();
  SLOAD16(KVBLK);
  qkt16<NS>(A, K_lds + koff, qf); exp16(A);
  asm volatile("s_waitcnt vmcnt(0)" ::: "memory"); SWRITE16(1); __syncthreads();
  int sp = 0, scur = 1, sn = 2;
#define RSTEP16(X, Y, TJ) do { \
    SLOAD16(((TJ) + 1) * KVBLK); SBAR(); \
    if constexpr (A16_HS) { region1_16<NS>(X, K_lds + scur * SHM_K + koff, qf, Y, l, pa); region2_16(o, vb0 + sp * SHM_V16, pa, X); } else { \
    qkt16<NS>(X, K_lds + scur * SHM_K + koff, qf); \
    finish16(Y, l, pa); SBAR(); \
    pv16(o, vb0 + sp * SHM_V16, pa); exp16(X); } \
    asm volatile("s_waitcnt vmcnt(0)" ::: "memory"); SWRITE16(sn); __syncthreads(); \
    { const int t_ = sp; sp = scur; scur = sn; sn = t_; } } while (0)
  for (int j = 1; j + 1 < NT; j += 2) {
    RSTEP16(B, A, j);
    RSTEP16(A, B, j + 1);
  }
#undef RSTEP16
  SBAR(); qkt16<NS>(B, K_lds + scur * SHM_K + koff, qf);
  finish16(A, l, pa); SBAR();
  pv16(o, vb0 + sp * SHM_V16, pa); exp16(B);
  finish16(B, l, pa); SBAR();
  pv16(o, vb0 + scur * SHM_V16, pa);
  }
  { const float t0 = (l[0] + l[1]) + (l[2] + l[3]), t1 = (l[4] + l[5]) + (l[6] + l[7]); l[0] = t0; l[1] = t1; }
#pragma unroll
  for (int qg = 0; qg < 2; ++qg) { l[qg] += __shfl_xor(l[qg], 16); l[qg] += __shfl_xor(l[qg], 32); }
  if (g == 0) { li_l[c] = l[0]; li_l[16 + c] = l[1]; } asm volatile("s_waitcnt lgkmcnt(0)" ::: "memory");
#pragma unroll
  for (int qg = 0; qg < 2; ++qg)
#pragma unroll
    for (int r = 0; r < 4; ++r) { const float rl = __builtin_amdgcn_rcpf(li_l[qg * 16 + 4 * g + r]);
#pragma unroll
      for (int cb = 0; cb < 8; ++cb) o[qg][cb][r] *= rl; }
  __syncthreads();
#undef SLOAD16
#undef SWRITE16
}
}
#undef SBAR
}
#define GAS __attribute__((address_space(1)))
#define LAS __attribute__((address_space(3)))
typedef unsigned short bf16;
typedef unsigned v4u __attribute__((ext_vector_type(4)));
typedef float f32x4 __attribute__((ext_vector_type(4)));
typedef short bf16x8 __attribute__((ext_vector_type(8)));
typedef GAS unsigned gu32;
typedef GAS unsigned long long gu64;
#define RLX_AGENT __ATOMIC_RELAXED, __HIP_MEMORY_SCOPE_AGENT
#define LDS_WAIT() asm volatile("s_waitcnt lgkmcnt(0)" ::: "memory")
#define VM_WAIT() asm volatile("s_waitcnt vmcnt(0)" ::: "memory")
__device__ __forceinline__ unsigned long long rt() { return __builtin_amdgcn_s_memrealtime(); }
__device__ __forceinline__ unsigned f2bf(float f) { unsigned u = __builtin_bit_cast(unsigned, f); return (u + 0x7fffu + ((u >> 16) & 1u)) >> 16; }
__device__ __forceinline__ unsigned pk2(float lo, float hi) { return f2bf(lo) | (f2bf(hi) << 16); }

#define XB_TMO      128
#define XB_XCNT(j)  (256  + 64 * (j))
#define XB_XSUB(j)  (1280 + 64 * (j))
#define XB_XGEN(j)  (2304 + 64 * (j))
#define XB_TOP      3328
#define XB_TOPGEN   3392
#define XCD_BAR_WORDS 3456
#define XB_SPIN_CAP (1u << 18)

__device__ __forceinline__ unsigned xb_ld(unsigned* p)              { return __hip_atomic_load(p, __ATOMIC_RELAXED, __HIP_MEMORY_SCOPE_AGENT); }
__device__ __forceinline__ unsigned xb_add(unsigned* p, unsigned v) { return __hip_atomic_fetch_add(p, v, __ATOMIC_RELAXED, __HIP_MEMORY_SCOPE_AGENT); }
__device__ __forceinline__ unsigned xb_xcc_id() { return (unsigned)__builtin_amdgcn_s_getreg((3 << 11) | 20) & 0xFu; }
#define XB_SPIN(cond, bar) do { unsigned _sp = 0; while (cond) { __builtin_amdgcn_s_sleep(1); \
    if ((++_sp & 255u) == 0u) { if (xb_ld(&(bar)[XB_TMO])) break; if (_sp > XB_SPIN_CAP) { atomicAdd(&(bar)[XB_TMO], 1u); break; } } } } while (0)

struct XcdBarrier {
    unsigned* bar; unsigned x;
    volatile LAS unsigned* st;
};

__device__ __forceinline__ XcdBarrier xcd_barrier_post(unsigned* bar, volatile LAS unsigned* st) {
    XcdBarrier b; b.bar = bar; b.x = xb_xcc_id(); b.st = st;
    if (threadIdx.x == 0) (void)xb_add(&bar[XB_XCNT(b.x)], 1u);
    return b;
}
__device__ __forceinline__ void xcd_barrier_complete(unsigned* bar, unsigned x, unsigned& nloc, unsigned& nx) {
    const unsigned G = gridDim.x * gridDim.y * gridDim.z;
    unsigned sum, cnt, mine, sp = 0u;
    for (;;) {
        sum = 0u; cnt = 0u; mine = 0u;
#pragma unroll
        for (unsigned j = 0; j < 16; ++j) { const unsigned c = xb_ld(&bar[XB_XCNT(j)]); sum += c; cnt += (c > 0u) ? 1u : 0u; mine = (j == x) ? c : mine; }
        if (sum == G) break;
        __builtin_amdgcn_s_sleep(1);
        if ((++sp & 255u) == 0u) { if (xb_ld(&bar[XB_TMO])) break; if (sp > XB_SPIN_CAP) { atomicAdd(&bar[XB_TMO], 1u); break; } }
    }
    nloc = mine > 0u ? mine : 1u; nx = cnt > 0u ? cnt : 1u;
}

__device__ __forceinline__ void xcd_barrier(const XcdBarrier& b) {
    asm volatile("s_waitcnt vmcnt(0)" ::: "memory");
    __syncthreads();
    if (threadIdx.x == 0) {
        unsigned* bar = b.bar;
        __builtin_amdgcn_s_waitcnt(0);
        unsigned nloc = b.st[0], nx = b.st[1];
        if (nloc == 0u) { xcd_barrier_complete(bar, b.x, nloc, nx); b.st[0] = nloc; b.st[1] = nx; }
        const unsigned old = xb_add(&bar[XB_XSUB(b.x)], 1u);
        const unsigned gen = old / nloc;
        if (old + 1u == (gen + 1u) * nloc) {
            __builtin_amdgcn_fence(__ATOMIC_RELEASE, "agent");
            asm volatile("s_waitcnt vmcnt(0)" ::: "memory");
            const unsigned og = xb_add(&bar[XB_TOP], 1u);
            const unsigned tg = og / nx;
            if (og + 1u == (tg + 1u) * nx) xb_add(&bar[XB_TOPGEN], 1u);
            else XB_SPIN(xb_ld(&bar[XB_TOPGEN]) == tg, bar);
            __builtin_amdgcn_fence(__ATOMIC_ACQUIRE, "agent");
            xb_add(&bar[XB_XGEN(b.x)], 1u);
            asm volatile("s_waitcnt vmcnt(0)" ::: "memory");
        } else {
            XB_SPIN(xb_ld(&bar[XB_XGEN(b.x)]) == gen, bar);
            __builtin_amdgcn_fence(__ATOMIC_ACQUIRE, "agent");
            asm volatile("s_waitcnt vmcnt(0)" ::: "memory");
        }
    }
    __syncthreads();
}
constexpr int NWAVES = 8;
constexpr int SEQ = 8192, DM = 4096, NIN = 7232, NINP = 7424, FF = 11008, DEPTH = 2;
constexpr int A_HEADS = 12, A_KV = 4, B_HEADS = 8, C_HEADS = 12;
constexpr float EPS = 1e-6f;
#ifndef MK_PER_PHASE
#define MK_PER_PHASE 0
#endif
constexpr int N_PHASES = 1 + 8 * DEPTH;

constexpr size_t MiB = 1u << 20;
constexpr size_t WS_CTL = 0, CTL_ZERO_BYTES = 1 * MiB;
constexpr size_t WS_SSQ = 256 * 1024;
constexpr size_t WS_TCC = 2 * MiB, WS_TSC = 3 * MiB, WS_TCB = 4 * MiB, WS_TSB = 4 * MiB + 256 * 1024;
constexpr size_t WS_W0 = 8 * MiB;
constexpr size_t W_IN = 0, W_QUP = 58 * MiB, W_KVUP = 64 * MiB, W_OUT = 67 * MiB, W_GU = 99 * MiB, W_DOWN = 271 * MiB, W_LAYER = 357 * MiB;
constexpr size_t WS_ACT = WS_W0 + 2 * W_LAYER;
constexpr size_t WS_XN = WS_ACT, WS_QA = WS_XN + 64 * MiB, WS_KA = WS_QA + 24 * MiB, WS_VA = WS_KA + 8 * MiB, WS_QB = WS_VA + 8 * MiB, WS_KB = WS_QB + 16 * MiB,
                 WS_VB = WS_KB + 16 * MiB, WS_CQL = WS_VB + 16 * MiB, WS_CKVL = WS_CQL + 16 * MiB, WS_CKR = WS_CKVL + 8 * MiB, WS_QC = WS_CKR + 2 * MiB,
                 WS_KC = WS_QC + 36 * MiB, WS_VC = WS_KC + 36 * MiB, WS_Y = WS_VC + 24 * MiB, WS_ACTB = WS_Y + 64 * MiB, WS_STASH = WS_ACTB + 172 * MiB,
                 WS_END = WS_STASH + 32 * MiB;
static_assert((size_t)NINP * DM * 2 == 58 * MiB && (size_t)3072 * 1024 * 2 == 6 * MiB && (size_t)3072 * 512 * 2 == 3 * MiB && (size_t)DM * DM * 2 == 32 * MiB &&
              (size_t)2 * FF * DM * 2 == 172 * MiB && (size_t)DM * FF * 2 == 86 * MiB, "weight copy sizes");
static_assert((size_t)SEQ * FF * 2 == 172 * MiB && (size_t)SEQ * 2304 * 2 == 36 * MiB, "activation sizes");
constexpr int CW_BAR = 4096;

constexpr int RING_OFF = 0, RING_BYTES = 131072;
constexpr int EPI_OFF = RING_BYTES, EPI_BYTES = 16384;
constexpr int MISC_OFF = EPI_OFF + EPI_BYTES;
constexpr int LDS_BYTES = MISC_OFF + 512;
#define ATT_B_PASS att::attn_pass<4, ATT_SD_B, 0, true, ATT_NSLOT, 1024, 1024, 1024>
#define ATT_B_PASS_BND att::attn_pass<4, ATT_SD_B, 0, true, ATT_NSLOT, 1024, 1024, 1024, true>
#ifndef ATT_NSLOT
#define ATT_NSLOT 3
#endif
#ifndef ATT_SD_A
#define ATT_SD_A 1
#endif
#ifndef ATT_SD_B
#define ATT_SD_B 1
#endif
#ifndef CQL_PARK
#define CQL_PARK 4
#endif
static_assert(att::lds_bytes<12, CQL_PARK>() <= RING_BYTES + EPI_BYTES && att::lds_bytes<8, 0, ATT_NSLOT>() <= RING_BYTES && att::a16::lds_bytes<6>() <= RING_BYTES + EPI_BYTES && att::a16::lds_bytes<4>() <= RING_BYTES + EPI_BYTES, "attention LDS");

typedef unsigned v2u __attribute__((ext_vector_type(2)));
__device__ __forceinline__ unsigned cvtpk2(float lo, float hi) { unsigned r; asm volatile("v_cvt_pk_bf16_f32 %0, %1, %2" : "=v"(r) : "v"(lo), "v"(hi)); return r; }

struct Args { const float* in[20]; float* out; unsigned char* ws; int ph_lo, ph_hi; float lam_init[2]; int seq, pad; };

struct Frame {
    LAS unsigned char* lds; volatile LAS unsigned* MISC;
    int wave, vcu, G;
};
__device__ __forceinline__ int fresh_bx() { int b = (int)blockIdx.x; asm volatile("" : "+s"(b)); return b; }
#define FLANE (fresh_lane())
#define FTID (F.wave * 64 + fresh_lane())
__device__ __forceinline__ float wave_sum(float v) {
#pragma unroll
    for (int o = 1; o < 64; o <<= 1) v += __shfl_xor(v, o);
    return v;
}

template <int MAP> __device__ __forceinline__ int dest_row(int c) {
    if constexpr (MAP == 1) {
        if (c < 2048) { const int l = c & 127, hh = l >> 6, n = (l >> 5) & 1, w = (l >> 4) & 1, fq = (l >> 2) & 3, j = l & 3; return (c & ~127) + (hh * 2 + w) * 32 + fq * 8 + n * 4 + j; }
        if (c >= 2560 && c < 4608) { int l = c & 63; if (l < 16) l = ((l >> 2) & 1) * 8 + (l >> 3) * 4 + (l & 3); return (c & ~63) + l; }
        return c;
    } else if constexpr (MAP == 2) {
        const int h = c / 192, l = c - h * 192; if (l < 128) return h * 256 + l;
        const int lp = l - 128, n = lp >> 5, w = (lp >> 4) & 1, fq = (lp >> 2) & 3, j = lp & 3; return h * 256 + 128 + w * 32 + fq * 8 + n * 4 + j;
    } else if constexpr (MAP == 3) { return (c >> 7) * 256 + (c & 127);
    } else if constexpr (MAP == 4) { return (c >> 7) * 256 + 128 + (c & 127);
    } else return c;
}
__device__ __forceinline__ int dest_row_rt(int map, int c) { return map == 1 ? dest_row<1>(c) : map == 2 ? dest_row<2>(c) : map == 3 ? dest_row<3>(c) : map == 4 ? dest_row<4>(c) : c; }
__device__ __forceinline__ void cvt_items(const Frame& F, const float* __restrict__ W, int K, int N, unsigned short* WT, const float* kscale, int map, int it0, int it_end, int stride) {
    LAS float* scr = (LAS float*)(F.lds + RING_OFF + F.wave * 16384);
    int lane = FLANE; asm volatile("" : "+v"(lane));
    const int NGW = stride, nblk = N / 32, nkb = K / 64, sbi = nkb * 32, nitems = it_end;
    const int lr = lane >> 5, lc = lane & 31;
    float v[32];
    int it = it0;
#define CVT_DECODE(IT, KB, NB) const int sb_ = (IT) / sbi, loc_ = (IT) - sb_ * sbi, KB = loc_ >> 5, NB = sb_ * 32 + (loc_ & 31)
    if (it < nitems) { CVT_DECODE(it, kb, nb); if (nb < nblk) { const GAS float* src = (const GAS float*)W + (size_t)(64 * kb + lr) * N + 32 * nb + lc;
#pragma unroll
        for (int i = 0; i < 32; ++i) v[i] = __builtin_nontemporal_load(src + (size_t)(2 * i) * N); } }
    for (; it < nitems; it += NGW) {
        CVT_DECODE(it, kb, nb); const int k0 = 64 * kb, n0 = 32 * nb; const bool valid = nb < nblk;
        if (valid) {
        if (kscale) {
#pragma unroll
            for (int i = 0; i < 32; ++i) v[i] *= ((const GAS float*)kscale)[k0 + 2 * i + lr]; }
#pragma unroll
        for (int i = 0; i < 32; ++i) scr[(2 * i + lr) * 33 + lc] = v[i];
        }
        const int itn = it + NGW;
        if (itn < nitems) { CVT_DECODE(itn, kbn, nbn); if (nbn < nblk) { const GAS float* src = (const GAS float*)W + (size_t)(64 * kbn + lr) * N + 32 * nbn + lc;
#pragma unroll
            for (int i = 0; i < 32; ++i) v[i] = __builtin_nontemporal_load(src + (size_t)(2 * i) * N); } }
        if (!valid) continue;
        LDS_WAIT(); asm volatile("" ::: "memory");
        const int c = lane & 7;
#pragma unroll
        for (int j = 0; j < 4; ++j) { const int n = (lane >> 3) + 8 * j; const LAS float* s = scr + (8 * c) * 33 + n;
            v4u o; o.x = cvtpk2(s[0 * 33], s[1 * 33]); o.y = cvtpk2(s[2 * 33], s[3 * 33]); o.z = cvtpk2(s[4 * 33], s[5 * 33]); o.w = cvtpk2(s[6 * 33], s[7 * 33]);
            __builtin_nontemporal_store(o, (GAS v4u*)(WT + (size_t)dest_row_rt(map, n0 + n) * K + k0 + 8 * c)); }
        LDS_WAIT(); asm volatile("" ::: "memory");
    }
#undef CVT_DECODE
}

__host__ __device__ constexpr int cvt_nitems(int K, int N) { return ((N / 32 + 31) / 32) * (K / 64) * 32; }
template <int MAP> __device__ __forceinline__ void cvt_matrix(const Frame& F, const float* W, int K, int N, unsigned short* WT, const float* kscale) {
    cvt_items(F, W, K, N, WT, kscale, MAP, F.vcu * NWAVES + F.wave, cvt_nitems(K, N), F.G * NWAVES);
}

#ifndef CVT_PROBE
#define CVT_PROBE 0
#endif
__device__ __forceinline__ void cvt_probe_read(const Frame& F, const float* __restrict__ W, int K, int N) {
    int lane = FLANE; asm volatile("" : "+v"(lane));
    const int gw = F.vcu * NWAVES + F.wave, NGW = F.G * NWAVES, nblk = N / 32, nitems = (K / 64) * nblk;
    const int lr = lane >> 5, lc = lane & 31;
    float acc = 0.f;
    for (int it = gw; it < nitems; it += NGW) { const int kb = it / nblk, nb = it - kb * nblk; const float* src = W + (size_t)(64 * kb + lr) * N + 32 * nb + lc;
        float v[32];
#pragma unroll
        for (int i = 0; i < 32; ++i) v[i] = __builtin_nontemporal_load(src + (size_t)(2 * i) * N);
#pragma unroll
        for (int i = 0; i < 32; ++i) acc += v[i]; }
    asm volatile("" :: "v"(acc));
}

constexpr int QB = 64;
constexpr int QI_GATE = cvt_nitems(DM, FF), QI_DOWN = cvt_nitems(FF, DM), QI_IN = cvt_nitems(DM, NIN), QI_QUP = cvt_nitems(1024, 2304), QI_KVUP = cvt_nitems(512, 3072), QI_OUT = cvt_nitems(DM, DM);
constexpr int QG_FFN = 2 * QI_GATE + QI_DOWN, QG_EARLY = QI_IN + QI_QUP + QI_KVUP + QI_OUT;
constexpr int Q_END_A = QG_FFN, Q_END_B = Q_END_A + QG_EARLY, Q_END_C = Q_END_B + QG_FFN;
static_assert(QG_FFN % QB == 0 && QG_EARLY % QB == 0, "queue groups are whole batches");
constexpr int CW_QHEAD = 8192;
static_assert(QI_GATE % QB == 0 && QI_DOWN % QB == 0 && QI_IN % QB == 0 && QI_QUP % QB == 0 && QI_KVUP % QB == 0 && QI_OUT % QB == 0, "a batch never straddles two matrices");
template <class A> __device__ __forceinline__ void cvt_queue_range(const Frame& F, const A& args, unsigned char* ws, int g0, int g1) {
    typedef unsigned short bf;
    if (g1 > Q_END_C) g1 = Q_END_C;
    while (g0 < g1) {
    const float* W; const float* ks; bf* WT; int K, N, map, jb;
    if (g0 < Q_END_A || g0 >= Q_END_B) {
        const int l = g0 < Q_END_A ? 0 : 1, gb = l ? Q_END_B : 0, r = g0 - gb; unsigned char* wl = ws + WS_W0 + (size_t)l * W_LAYER;
        if (r < QI_GATE) { W = args.in[17] + (size_t)l * DM * FF; K = DM; N = FF; WT = (bf*)(wl + W_GU); ks = args.in[16] + l * DM; map = 3; jb = gb; }
        else if (r < 2 * QI_GATE) { W = args.in[18] + (size_t)l * DM * FF; K = DM; N = FF; WT = (bf*)(wl + W_GU); ks = args.in[16] + l * DM; map = 4; jb = gb + QI_GATE; }
        else { W = args.in[19] + (size_t)l * FF * DM; K = FF; N = DM; WT = (bf*)(wl + W_DOWN); ks = nullptr; map = 0; jb = gb + 2 * QI_GATE; }
    } else {
        const int l = 1, gb = Q_END_A, r = g0 - gb; unsigned char* wl = ws + WS_W0 + (size_t)l * W_LAYER;
        if (r < QI_IN) { W = args.in[2] + (size_t)l * DM * NIN; K = DM; N = NIN; WT = (bf*)(wl + W_IN); ks = args.in[1] + l * DM; map = 1; jb = gb; }
        else if (r < QI_IN + QI_QUP) { W = args.in[11] + (size_t)l * 1024 * 2304; K = 1024; N = 2304; WT = (bf*)(wl + W_QUP); ks = args.in[9] + l * 1024; map = 2; jb = gb + QI_IN; }
        else if (r < QI_IN + QI_QUP + QI_KVUP) { W = args.in[12] + (size_t)l * 512 * 3072; K = 512; N = 3072; WT = (bf*)(wl + W_KVUP); ks = args.in[10] + l * 512; map = 0; jb = gb + QI_IN + QI_QUP; }
        else { W = args.in[15] + (size_t)l * DM * DM; K = DM; N = DM; WT = (bf*)(wl + W_OUT); ks = nullptr; map = 0; jb = gb + QI_IN + QI_QUP + QI_KVUP; }
    }
    const int je = jb + cvt_nitems(K, N), ge = g1 < je ? g1 : je;
    cvt_items(F, W, K, N, WT, ks, map, g0 - jb + F.wave, ge - jb, NWAVES);
    g0 = ge; }
}
constexpr int QMB = 8;
template <class A> __device__ __forceinline__ void xcd_barrier_steal(const XcdBarrier& b, const Frame& F, const A& args, unsigned char* ws) {
    asm volatile("s_waitcnt vmcnt(0)" ::: "memory");
    __syncthreads();
    volatile LAS unsigned* st = b.st;
    if (threadIdx.x == 0) {
        unsigned* bar = b.bar;
        __builtin_amdgcn_s_waitcnt(0);
        unsigned nloc = st[0], nx = st[1];
        if (nloc == 0u) { xcd_barrier_complete(bar, b.x, nloc, nx); st[0] = nloc; st[1] = nx; }
        const unsigned old = xb_add(&bar[XB_XSUB(b.x)], 1u);
        const unsigned gen = old / nloc;
        if (old + 1u == (gen + 1u) * nloc) {
            __builtin_amdgcn_fence(__ATOMIC_RELEASE, "agent");
            asm volatile("s_waitcnt vmcnt(0)" ::: "memory");
            const unsigned og = xb_add(&bar[XB_TOP], 1u);
            const unsigned tg = og / nx;
            if (og + 1u == (tg + 1u) * nx) xb_add(&bar[XB_TOPGEN], 1u);
            else XB_SPIN(xb_ld(&bar[XB_TOPGEN]) == tg, bar);
            __builtin_amdgcn_fence(__ATOMIC_ACQUIRE, "agent");
            xb_add(&bar[XB_XGEN(b.x)], 1u);
            asm volatile("s_waitcnt vmcnt(0)" ::: "memory");
            st[2] = 0u;
        } else { st[2] = 1u; st[3] = gen; }
    }
    __syncthreads();
    gu32* qhead = (gu32*)(ws + WS_CTL) + CW_QHEAD;
    for (unsigned it = 0; st[2] != 0u; ++it) {
        if (threadIdx.x == 0) { unsigned g_ = 0x7fffffffu;
            if (__hip_atomic_load(qhead, __ATOMIC_RELAXED, __HIP_MEMORY_SCOPE_AGENT) < (unsigned)Q_END_C) g_ = __hip_atomic_fetch_add(qhead, (unsigned)QMB, __ATOMIC_RELAXED, __HIP_MEMORY_SCOPE_AGENT);
            st[4] = g_; }
        __syncthreads();
        const int g = (int)st[4];
        if (g < Q_END_C) cvt_queue_range(F, args, ws, g, g + QMB); else __builtin_amdgcn_s_sleep(8);
        asm volatile("s_waitcnt vmcnt(0)" ::: "memory");
        __syncthreads();
        if (threadIdx.x == 0) { unsigned* bar = b.bar; bool done = xb_ld(&bar[XB_XGEN(b.x)]) != st[3];
            if (!done && (it & 63u) == 63u) { if (xb_ld(&bar[XB_TMO])) done = true; else if (it > XB_SPIN_CAP) { atomicAdd(&bar[XB_TMO], 1u); done = true; } }
            if (done) { __builtin_amdgcn_fence(__ATOMIC_ACQUIRE, "agent"); asm volatile("s_waitcnt vmcnt(0)" ::: "memory"); st[2] = 0u; } }
        __syncthreads();
    }
}
template <class A> __device__ __forceinline__ void cvt_steal(const Frame& F, const A& args, unsigned char* ws, int quota, int upto) {
    gu32* qhead = (gu32*)(ws + WS_CTL) + CW_QHEAD;
    __syncthreads();
    for (int b = 0; b < quota || upto > 0; ++b) {
        if (FTID == 0) { unsigned g_ = 0x7fffffffu;
            if (b < quota || __hip_atomic_load(qhead, __ATOMIC_RELAXED, __HIP_MEMORY_SCOPE_AGENT) < (unsigned)upto) g_ = __hip_atomic_fetch_add(qhead, (unsigned)QB, __ATOMIC_RELAXED, __HIP_MEMORY_SCOPE_AGENT);
            F.MISC[16 + (b & 1)] = g_; }
        __syncthreads();
        const int g = (int)F.MISC[16 + (b & 1)];
        if (g >= Q_END_C) break;
        cvt_queue_range(F, args, ws, g, g + QB);
    }
    __syncthreads();
}
__device__ __forceinline__ void norm_rows(const Frame& F, const float* src, const float* gain, unsigned short* dst) {
    int lane = FLANE; asm volatile("" : "+v"(lane));
    const int gw = F.vcu * NWAVES + F.wave, NGW = F.G * NWAVES;
    for (int m = gw; m < SEQ; m += NGW) {
        const GAS f32x4* xr = (const GAS f32x4*)(src + (size_t)m * DM) + lane;
        f32x4 v[16]; float s = 0.f;
#pragma unroll
        for (int j = 0; j < 16; ++j) { v[j] = xr[64 * j]; s += (v[j].x * v[j].x + v[j].y * v[j].y) + (v[j].z * v[j].z + v[j].w * v[j].w); }
        const float rstd = rsqrtf(wave_sum(s) * (1.0f / DM) + EPS);
        GAS v2u* o8 = (GAS v2u*)(dst + (size_t)m * DM) + lane;
#pragma unroll
        for (int j = 0; j < 16; ++j) { const f32x4 g = *((const GAS f32x4*)gain + lane + 64 * j); v2u w; w.x = cvtpk2(v[j].x * rstd * g.x, v[j].y * rstd * g.y); w.y = cvtpk2(v[j].z * rstd * g.z, v[j].w * rstd * g.w); o8[64 * j] = w; }
    }
}
__device__ __forceinline__ void cast_rows(const Frame& F, const float* src, unsigned short* dst, float* ssq) {
    int lane = FLANE; asm volatile("" : "+v"(lane));
    const int gw = F.vcu * NWAVES + F.wave, NGW = F.G * NWAVES;
    for (int m = gw; m < SEQ; m += NGW) {
        const GAS f32x4* xr = (const GAS f32x4*)(src + (size_t)m * DM) + lane;
        f32x4 v[16]; float s = 0.f;
#pragma unroll
        for (int j = 0; j < 16; ++j) { v[j] = xr[64 * j]; s += (v[j].x * v[j].x + v[j].y * v[j].y) + (v[j].z * v[j].z + v[j].w * v[j].w); }
        s = wave_sum(s); if (lane == 0) ssq[m] = s;
        GAS v2u* o8 = (GAS v2u*)(dst + (size_t)m * DM) + lane;
#pragma unroll
        for (int j = 0; j < 16; ++j) { v2u w; w.x = cvtpk2(v[j].x, v[j].y); w.y = cvtpk2(v[j].z, v[j].w); o8[64 * j] = w; }
    }
}
__device__ __forceinline__ void sincos_d(float ang, float& sn, float& cs) {
    const double a = (double)ang; const double kq = __builtin_rint(a * 0.63661977236758134308);
    double r = __builtin_fma(-kq, 1.57079632679489655800e+00, a); r = __builtin_fma(-kq, 6.12323399573676603587e-17, r);
    const int q = (int)kq & 3; const double r2 = r * r;
    const double sp = r + r * r2 * (-1.66666666666666666667e-01 + r2 * (8.33333333333333333333e-03 + r2 * (-1.98412698412698412698e-04 + r2 * (2.75573192239858906526e-06 + r2 * (-2.50521083854417187751e-08 + r2 * 1.60590438368216145994e-10)))));
    const double cp = 1.0 + r2 * (-0.5 + r2 * (4.16666666666666666667e-02 + r2 * (-1.38888888888888888889e-03 + r2 * (2.48015873015873015873e-05 + r2 * (-2.75573192239858906526e-07 + r2 * (2.08767569878680989792e-09 + r2 * -1.14707455977297247139e-11))))));
    const double s = (q & 1) ? cp : sp, c = (q & 1) ? sp : cp;
    sn = (float)((q & 2) ? -s : s); cs = (float)(((q + 1) & 2) ? -c : c);
}
__device__ __forceinline__ void rope_tables(const Frame& F, float* tcC, float* tsC, float* tcB, float* tsB) {
    const int gt = F.vcu * (NWAVES * 64) + FTID, NT = F.G * NWAVES * 64;
    for (int e = gt; e < SEQ * 40; e += NT) {
        const bool isC = e < SEQ * 32; const int ee = isC ? e : e - SEQ * 32; const int pos = isC ? (ee >> 5) : (ee >> 3), i = isC ? (ee & 31) : (ee & 7);
        const double rr = isC ? 0.7498942093324559   : 0.19392274474868576  ;
        double p = 1.0; for (int k = 0; k < i; ++k) p *= rr;
        const float inv = (float)p, ang = (float)pos * inv; float sn, cs; sincos_d(ang, sn, cs);
        if (isC) { tcC[ee] = cs; tsC[ee] = sn; } else { tcB[ee] = cs; tsB[ee] = sn; }
    }
}

__device__ __forceinline__ int attn_unit_id(int G, int bx, int i) {
    if (G == 256) { const int x = bx & 7, r = bx >> 3, y = x >> 1;
        if ((x & 1) == 0) { if (i == 0) return x * 32 + r; if (i == 1) return 256 + y * 96 + r; if (i == 2) return 256 + y * 96 + 32 + r; if (i == 3) return 640 + (3 * y) * 32 + r; }
        else { if (i == 0) return 256 + y * 96 + 64 + r; if (i == 1) return 640 + (3 * y + 1) * 32 + r; if (i == 2) return 640 + (3 * y + 2) * 32 + r; if (i == 3) return x * 32 + r; }
        return -1; }
    const int id = bx + i * G; return id < 1024 ? id : -1;
}
struct AttnPtrs { const unsigned short *QA, *KA, *VA, *QB, *KB, *VB, *QC, *KC, *VC; unsigned short* Y; float* stash; const float *lam_p, *subln; float lam_init; int seq;
                  const float *gqA, *gkA, *gqB, *gkB, *gqC, *gkC; };
__device__ __forceinline__ float wave_max(float v) {
#pragma unroll
    for (int o = 1; o < 64; o <<= 1) v = fmaxf(v, __shfl_xor(v, o));
    return v;
}
constexpr float BND_LIM = 64.f;
template <int D> __device__ __forceinline__ bool score_bounded(const float* gq, const float* gk, int lane) {
    float mq = 0.f, mk = 0.f;
#pragma unroll
    for (int i = 0; i < (D + 63) / 64; ++i) { const int j = lane + 64 * i; if (j < D) { mq = fmaxf(mq, fabsf(gq[j])); mk = fmaxf(mk, fabsf(gk[j])); } }
    const float b = wave_max(mq) * wave_max(mk) * (__builtin_sqrtf((float)D) * 1.4426950408889634f * 1.01f);
    return __builtin_amdgcn_readfirstlane((int)(b <= BND_LIM)) != 0;
}
__device__ __forceinline__ void store_o_bf16(const att::f32x16 (&o)[4], unsigned short* Yw, int r32, int hi) {
#pragma unroll
    for (int r = 0; r < 16; ++r) { const int orow = att::crow(r, hi);
#pragma unroll
        for (int d0 = 0; d0 < 4; ++d0) Yw[(size_t)orow * DM + d0 * 32 + r32] = (unsigned short)(cvtpk2(o[d0][r], 0.f) & 0xffffu); }
}
#ifndef ATT_BND
#define ATT_BND 1
#endif
#ifndef C_BND_DBL
#define C_BND_DBL 0
#endif
#ifndef C_BND_QL
#define C_BND_QL (C_BND_DBL ? 1 : CQL_PARK_BND)
#endif
#ifndef CQL_PARK_BND
#define CQL_PARK_BND CQL_PARK
#endif
#ifndef ATT16
#define ATT16 3
#endif
__device__ __forceinline__ void store_o16(const att::a16::f32x4 (&o)[2][8], unsigned short* Yw, int c16, int g4) {
#pragma unroll
    for (int qg = 0; qg < 2; ++qg)
#pragma unroll
        for (int r = 0; r < 4; ++r)
#pragma unroll
            for (int cb = 0; cb < 8; ++cb) Yw[(size_t)(qg * 16 + 4 * g4 + r) * DM + cb * 16 + c16] = (unsigned short)(cvtpk2(o[qg][cb][r], 0.f) & 0xffffu);
}
__device__ __forceinline__ void attn_phase(const Frame& F, const AttnPtrs& T, char* lds) {
    for (int i = 0;; ++i) {
        const int id = attn_unit_id(F.G, (int)blockIdx.x, i); if (id < 0) break;
        const int lane = fresh_lane(), wid = F.wave, tid = wid * 64 + lane;
        att::f32x16 o[4];
#ifndef ATT_MASK
#define ATT_MASK 7
#endif
        if (id < 256) { if constexpr ((ATT_MASK & 1) != 0) {
            const int h = id >> 5, t0 = (id & 31) * 256;
            float s1 = T.lam_p[lane] * T.lam_p[64 + lane], s2 = T.lam_p[128 + lane] * T.lam_p[192 + lane];
            s1 = wave_sum(s1); s2 = wave_sum(s2);
            const float lam = __builtin_amdgcn_exp2f(s1 * 1.4426950408889634f) - __builtin_amdgcn_exp2f(s2 * 1.4426950408889634f) + T.lam_init;
            f32x4* st4 = (f32x4*)(T.stash + (size_t)blockIdx.x * 32768 + tid * 64);
            const bool bnd = ATT_BND && score_bounded<64>(T.gqB, T.gkB, lane);
            if ((ATT16 & 1) != 0 && bnd) {
                att::a16::f32x4 o6[2][8]; const int c16 = lane & 15, g4 = lane >> 4;
                att::a16::attn_pass16<2, 1024, 1024, 1024>(T.QB + (size_t)t0 * 1024 + (2 * h) * 64, T.KB + (2 * h) * 64, T.VB + h * 128, T.seq, lds, o6, F.wave);
#pragma unroll
                for (int qg = 0; qg < 2; ++qg)
#pragma unroll
                    for (int cb = 0; cb < 8; ++cb) st4[qg * 8 + cb] = o6[qg][cb];
                asm volatile("" ::: "memory");
                att::a16::attn_pass16<2, 1024, 1024, 1024>(T.QB + (size_t)t0 * 1024 + (2 * h + 1) * 64, T.KB + (2 * h + 1) * 64, T.VB + h * 128, T.seq, lds, o6, F.wave);
                float li_ = T.lam_init; asm volatile("" : "+s"(li_)); const float post = 1.0f - li_;
                float gn[8];
#pragma unroll
                for (int cb = 0; cb < 8; ++cb) gn[cb] = T.subln[cb * 16 + c16] * post;
#pragma unroll
                for (int qg = 0; qg < 2; ++qg) { f32x4 s1v[8];
#pragma unroll
                    for (int cb = 0; cb < 8; ++cb) s1v[cb] = st4[qg * 8 + cb];
#pragma unroll
                    for (int r = 0; r < 4; ++r) { float q = 0.f;
#pragma unroll
                        for (int cb = 0; cb < 8; ++cb) { const float v = s1v[cb][r] - lam * o6[qg][cb][r]; o6[qg][cb][r] = v; q += v * v; }
                        q += __shfl_xor(q, 1); q += __shfl_xor(q, 2); q += __shfl_xor(q, 4); q += __shfl_xor(q, 8);
                        const float rstd = rsqrtf(q * (1.0f / 128.0f) + EPS);
#pragma unroll
                        for (int cb = 0; cb < 8; ++cb) o6[qg][cb][r] = o6[qg][cb][r] * rstd * gn[cb]; }
                    asm volatile("" ::: "memory"); }
                store_o16(o6, T.Y + (size_t)(t0 + wid * 32) * DM + 1536 + h * 128, c16, g4);
            } else {
            if ((ATT16 & 1) == 0 && bnd) ATT_B_PASS_BND(T.QB + (size_t)t0 * 1024 + (2 * h) * 64, T.KB + (2 * h) * 64, T.VB + h * 128, T.seq, lds, att::THRL, o, F.wave);
            else ATT_B_PASS(T.QB + (size_t)t0 * 1024 + (2 * h) * 64, T.KB + (2 * h) * 64, T.VB + h * 128, T.seq, lds, att::THRL, o, F.wave);
#pragma unroll
            for (int d0 = 0; d0 < 4; ++d0)
#pragma unroll
                for (int rg = 0; rg < 4; ++rg) st4[d0 * 4 + rg] = (f32x4){o[d0][4 * rg], o[d0][4 * rg + 1], o[d0][4 * rg + 2], o[d0][4 * rg + 3]};
            asm volatile("" ::: "memory");
            if ((ATT16 & 1) == 0 && bnd) ATT_B_PASS_BND(T.QB + (size_t)t0 * 1024 + (2 * h + 1) * 64, T.KB + (2 * h + 1) * 64, T.VB + h * 128, T.seq, lds, att::THRL, o, F.wave);
            else ATT_B_PASS(T.QB + (size_t)t0 * 1024 + (2 * h + 1) * 64, T.KB + (2 * h + 1) * 64, T.VB + h * 128, T.seq, lds, att::THRL, o, F.wave);
            float li_ = T.lam_init; asm volatile("" : "+s"(li_)); const float post = 1.0f - li_;
            float g[4];
#pragma unroll
            for (int d0 = 0; d0 < 4; ++d0) g[d0] = T.subln[d0 * 32 + (fresh_lane() & 31)] * post;
#pragma unroll
            for (int rg = 0; rg < 4; ++rg) { f32x4 s1v[4];
#pragma unroll
                for (int d0 = 0; d0 < 4; ++d0) s1v[d0] = st4[d0 * 4 + rg];
#pragma unroll
                for (int k = 0; k < 4; ++k) { const int r = 4 * rg + k; float q = 0.f;
#pragma unroll
                    for (int d0 = 0; d0 < 4; ++d0) { const float v = s1v[d0][k] - lam * o[d0][r]; o[d0][r] = v; q += v * v; }
                    q += __shfl_xor(q, 1); q += __shfl_xor(q, 2); q += __shfl_xor(q, 4); q += __shfl_xor(q, 8); q += __shfl_xor(q, 16);
                    const float rstd = rsqrtf(q * (1.0f / 128.0f) + EPS);
#pragma unroll
                    for (int d0 = 0; d0 < 4; ++d0) o[d0][r] = o[d0][r] * rstd * g[d0]; }
                asm volatile("" ::: "memory"); }
            { const int fl_ = fresh_lane(); store_o_bf16(o, T.Y + (size_t)(t0 + wid * 32) * DM + 1536 + h * 128, fl_ & 31, fl_ >> 5); } }
        } } else if (id < 640) { if constexpr ((ATT_MASK & 2) != 0) {
            const int a = id - 256, kvg = a / 96, rem = a - kvg * 96, h = kvg * 3 + (rem >> 5), t0 = (rem & 31) * 256;
            const bool bndA = ATT_BND && score_bounded<128>(T.gqA, T.gkA, lane);
            if ((ATT16 & 2) != 0 && bndA) {
                att::a16::f32x4 o6[2][8];
                att::a16::attn_pass16<4, 1536, 512, 512>(T.QA + (size_t)t0 * 1536 + h * 128, T.KA + kvg * 128, T.VA + kvg * 128, T.seq, lds, o6, F.wave);
                store_o16(o6, T.Y + (size_t)(t0 + wid * 32) * DM + h * 128, lane & 15, lane >> 4);
            } else {
            if ((ATT16 & 2) == 0 && bndA) att::attn_pass<8, ATT_SD_A, 0, true, ATT_NSLOT, 1536, 512, 512, true>(T.QA + (size_t)t0 * 1536 + h * 128, T.KA + kvg * 128, T.VA + kvg * 128, T.seq, lds, att::THRL, o, F.wave);
            else att::attn_pass<8, ATT_SD_A, 0, true, ATT_NSLOT, 1536, 512, 512>(T.QA + (size_t)t0 * 1536 + h * 128, T.KA + kvg * 128, T.VA + kvg * 128, T.seq, lds, att::THRL, o, F.wave);
            { const int fl_ = fresh_lane(); store_o_bf16(o, T.Y + (size_t)(t0 + wid * 32) * DM + h * 128, fl_ & 31, fl_ >> 5); } }
        } } else { if constexpr ((ATT_MASK & 4) != 0) {
            const int c = id - 640, h = c >> 5, t0 = (c & 31) * 256;
            const bool bndC = ATT_BND && score_bounded<192>(T.gqC, T.gkC, lane);
            if ((ATT16 & 4) != 0 && bndC) {
                att::a16::f32x4 o6[2][8];
                att::a16::attn_pass16<6, 2304, 2304, 1536>(T.QC + (size_t)t0 * 2304 + h * 192, T.KC + h * 192, T.VC + h * 128, T.seq, lds, o6, F.wave);
                store_o16(o6, T.Y + (size_t)(t0 + wid * 32) * DM + 2560 + h * 128, lane & 15, lane >> 4);
            } else {
            if ((ATT16 & 4) == 0 && bndC) att::attn_pass<12, 1, C_BND_QL, C_BND_DBL, C_BND_DBL ? 3 : 2, 2304, 2304, 1536, true>(T.QC + (size_t)t0 * 2304 + h * 192, T.KC + h * 192, T.VC + h * 128, T.seq, lds, att::THRL, o, F.wave);
            else att::attn_pass<12, 1, CQL_PARK, false, 2, 2304, 2304, 1536>(T.QC + (size_t)t0 * 2304 + h * 192, T.KC + h * 192, T.VC + h * 128, T.seq, lds, att::THRL, o, F.wave);
            { const int fl_ = fresh_lane(); store_o_bf16(o, T.Y + (size_t)(t0 + wid * 32) * DM + 2560 + h * 128, fl_ & 31, fl_ >> 5); } }
        } }
    }
}

#ifndef PROBE_GEMM
#define PROBE_GEMM 0
#endif
#ifndef Q_INPROJ
#define Q_INPROJ 4
#define Q_CUP 1
#define Q_ATTN 2
#define Q_GATEUP 4
#endif
__global__ void __launch_bounds__(NWAVES * 64, 2) hybrid_fwd(Args args) {
    extern __shared__ __attribute__((aligned(16))) unsigned char lds[];
    Frame F;
    F.lds = (LAS unsigned char*)lds; F.MISC = (volatile LAS unsigned*)(F.lds + MISC_OFF);
    F.wave = __builtin_amdgcn_readfirstlane((int)(threadIdx.x >> 6));
    F.G = gridDim.x; { const int bx = blockIdx.x; F.vcu = (F.G % 8 == 0) ? (bx % 8) * (F.G / 8) + bx / 8 : bx; }
    unsigned char* ws = args.ws;
    for (int u = (int)threadIdx.x; u < (LDS_BYTES - MISC_OFF) / 4; u += NWAVES * 64) ((LAS unsigned*)(F.lds + MISC_OFF))[u] = 0u;
    __syncthreads();
    XcdBarrier bar; bar.bar = (unsigned*)(ws + WS_CTL) + CW_BAR; bar.x = 0; bar.st = nullptr;
    if (!MK_PER_PHASE) bar = xcd_barrier_post((unsigned*)(ws + WS_CTL) + CW_BAR, F.MISC + 8);
    const int lo = args.ph_lo, hi = args.ph_hi;
#ifndef PH_MASK
#define PH_MASK 0x1ff
#endif
#define PK(b) (((PH_MASK) >> (b)) & 1)
#ifndef PH_REP
#define PH_REP 0
#endif
#define REP(b) (1 + (((PH_REP) >> (b)) & 1))
#define IN(k) (lo <= (k) && (k) < hi)
#ifndef BAR_STEAL
#define BAR_STEAL 0
#endif
#define SEAM(k) do { if (!MK_PER_PHASE && IN(k) && IN((k) + 1)) { if (BAR_STEAL) xcd_barrier_steal(bar, F, args, ws); else xcd_barrier(bar); } } while (0)
    typedef unsigned short bf;
#define WSP(T, off) ((T*)(GAS T*)(wsl + (off)))
#define LOCAL_PTRS GAS unsigned char* wsl = (GAS unsigned char*)ws; asm volatile("" : "+s"(wsl)); \
    float* tcC = WSP(float, WS_TCC); float* tsC = WSP(float, WS_TSC); float* tcB = WSP(float, WS_TCB); float* tsB = WSP(float, WS_TSB); \
    bf* XN = WSP(bf, WS_XN); bf* QA = WSP(bf, WS_QA); bf* KA = WSP(bf, WS_KA); bf* VA = WSP(bf, WS_VA); bf* QB = WSP(bf, WS_QB); bf* KB = WSP(bf, WS_KB); bf* VB = WSP(bf, WS_VB); \
    bf* CQL = WSP(bf, WS_CQL); bf* CKVL = WSP(bf, WS_CKVL); float* CKR = WSP(float, WS_CKR); bf* QC = WSP(bf, WS_QC); bf* KC = WSP(bf, WS_KC); bf* VC = WSP(bf, WS_VC); \
    bf* Y = WSP(bf, WS_Y); bf* ACT = WSP(bf, WS_ACTB); float* STASH = WSP(float, WS_STASH); \
    unsigned char* wl = (unsigned char*)(wsl + WS_W0 + (size_t)l * W_LAYER); float* SSQ = WSP(float, WS_SSQ) + (size_t)l * 3 * SEQ; float* SSQH = WSP(float, WS_SSQ) + 9 * SEQ; \
    (void)tcC; (void)tsC; (void)tcB; (void)tsB; (void)XN; (void)QA; (void)KA; (void)VA; (void)QB; (void)KB; (void)VB; (void)CQL; (void)CKVL; (void)CKR; (void)QC; (void)KC; (void)VC; (void)Y; (void)ACT; (void)STASH; (void)wl; (void)SSQ; (void)SSQH
    PG8_LAS float* EP = (PG8_LAS float*)(F.lds + EPI_OFF);
    PG8_LAS unsigned char* ring = (PG8_LAS unsigned char*)(F.lds + RING_OFF);

    for (int rep_ = 0; rep_ < REP(0); ++rep_) if (PK(0) && IN(0)) { const int l = 0; LOCAL_PTRS;
        {
            cvt_matrix<1>(F, args.in[2] + (size_t)l * DM * NIN, DM, NIN, (bf*)(wl + W_IN), args.in[1] + l * DM);
            cvt_matrix<2>(F, args.in[11] + (size_t)l * 1024 * 2304, 1024, 2304, (bf*)(wl + W_QUP), args.in[9] + l * 1024);
            cvt_matrix<0>(F, args.in[12] + (size_t)l * 512 * 3072, 512, 3072, (bf*)(wl + W_KVUP), args.in[10] + l * 512);
            cvt_matrix<0>(F, args.in[15] + (size_t)l * DM * DM, DM, DM, (bf*)(wl + W_OUT), nullptr); }
        rope_tables(F, tcC, tsC, tcB, tsB);
        cast_rows(F, args.in[0], XN, SSQH);
    }
    SEAM(0);
    for (int l = 0; l < DEPTH; ++l) {
        const int pb = 1 + 8 * l;
        if (PK(1) && IN(pb + 0)) { __builtin_amdgcn_s_waitcnt(0); LOCAL_PTRS;
            pg8::Gemm g{XN, (const bf*)(wl + W_IN), SEQ, NINP, DM}; pg8::StaticOrder S; S.init(SEQ, NINP, F.G, (int)blockIdx.x);
            pg8::EpiInProj E{QA, KA, VA, QB, KB, VB, CQL, CKVL, CKR, SSQ, SSQ + SEQ, SSQ + 2 * SEQ,
                             args.in[3] + l * 128, args.in[4] + l * 128, args.in[5] + l * 64, args.in[6] + l * 64, tcC, tsC, tcB, tsB, EP, SSQH + (size_t)(2 * l) * SEQ};
            pg8::gemm_phase<pg8::EpiInProj, pg8::StaticOrder, true, true>(ring, g, S, E, F.wave);
            cvt_steal(F, args, ws, (fresh_bx() >= 160 && F.G == 256) ? Q_INPROJ : 0, 0);
            if (PROBE_GEMM == 2) { float* SD_ = (float*)(ws + WS_SSQ) + 6 * SEQ; pg8::EpiInProj E2 = E; E2.SSQ_Q = SD_; E2.SSQ_KV = SD_ + SEQ; E2.SSQ_KR = SD_ + 2 * SEQ; pg8::gemm_phase<pg8::EpiInProj, pg8::StaticOrder, true, true>(ring, g, S, E2, F.wave); }
        }
        SEAM(pb + 0);
        for (int rep_ = 0; rep_ < REP(2); ++rep_) if (PK(2) && IN(pb + 1)) { __builtin_amdgcn_s_waitcnt(0); LOCAL_PTRS;
            { pg8::Gemm g{CQL, (const bf*)(wl + W_QUP), SEQ, 3072, 1024}; pg8::StaticOrder S; S.init(SEQ, 3072, F.G, (int)blockIdx.x);
              pg8::EpiQUp E{QC, SSQ, args.in[13] + l * 192, tcC, tsC, EP};
              pg8::gemm_phase<pg8::EpiQUp, pg8::StaticOrder, true, true>(ring, g, S, E, F.wave); }
            { pg8::Gemm g{CKVL, (const bf*)(wl + W_KVUP), SEQ, 3072, 512}; pg8::StaticOrder S; S.init(SEQ, 3072, F.G, (int)blockIdx.x);
              pg8::EpiKVUp E{KC, VC, SSQ + SEQ, SSQ + 2 * SEQ, CKR, args.in[14] + l * 192, tcC, tsC, EP};
              pg8::gemm_phase<pg8::EpiKVUp, pg8::StaticOrder, true, true>(ring, g, S, E, F.wave); }
            cvt_steal(F, args, ws, (fresh_bx() >= 128 && F.G == 256) ? Q_CUP : 0, 0);
        }
        SEAM(pb + 1);
        for (int rep_ = 0; rep_ < REP(3); ++rep_) if (PK(3) && IN(pb + 2)) { __builtin_amdgcn_s_waitcnt(0); LOCAL_PTRS;
            const AttnPtrs T{QA, KA, VA, QB, KB, VB, QC, KC, VC, Y, STASH, args.in[7] + l * 256, args.in[8] + l * 128, args.lam_init[l], args.seq,
                             args.in[3] + l * 128, args.in[4] + l * 128, args.in[5] + l * 64, args.in[6] + l * 64, args.in[13] + l * 192, args.in[14] + l * 192};
            attn_phase(F, T, (char*)lds + RING_OFF);
            cvt_steal(F, args, ws, ((fresh_bx() & 1) == 0 && F.G == 256) ? Q_ATTN : 0, 0);
        }
        SEAM(pb + 2);
        if (PK(4) && IN(pb + 3)) { __builtin_amdgcn_s_waitcnt(0); LOCAL_PTRS;
            pg8::Gemm g{Y, (const bf*)(wl + W_OUT), SEQ, DM, DM}; pg8::StaticOrder S; S.init(SEQ, DM, F.G, (int)blockIdx.x);
            pg8::EpiResid E{XN, nullptr, DM, SSQH + (size_t)(2 * l + 1) * SEQ};
            pg8::gemm_phase<pg8::EpiResid, pg8::StaticOrder, true, true>(ring, g, S, E, F.wave);
            cvt_steal(F, args, ws, 0, (l == 0 ? 0 : Q_END_B) + 2 * QI_GATE);
        }
        SEAM(pb + 3);
        for (int rep_ = 0; rep_ < REP(6); ++rep_) if (PK(6) && IN(pb + 5)) { __builtin_amdgcn_s_waitcnt(0); LOCAL_PTRS;
            pg8::Gemm g{XN, (const bf*)(wl + W_GU), SEQ, 2 * FF, DM}; pg8::StaticOrder S; S.init(SEQ, 2 * FF, F.G, (int)blockIdx.x);
            pg8::EpiGateUp E{ACT, FF, SSQH + (size_t)(2 * l + 1) * SEQ};
            pg8::gemm_phase<pg8::EpiGateUp, pg8::StaticOrder, true, true>(ring, g, S, E, F.wave);
            cvt_steal(F, args, ws, (fresh_bx() >= 192 && F.G == 256) ? Q_GATEUP : 0, l == 0 ? Q_END_A : Q_END_C);
        }
        SEAM(pb + 5);
        if (PK(7) && IN(pb + 6)) { __builtin_amdgcn_s_waitcnt(0); LOCAL_PTRS;
            pg8::Gemm g{ACT, (const bf*)(wl + W_DOWN), SEQ, DM, FF}; pg8::StaticOrder S; S.init(SEQ, DM, F.G, (int)blockIdx.x);
            pg8::EpiResid E{XN, (l + 1 < DEPTH) ? nullptr : args.out, DM, SSQH + (size_t)(2 * l + 2) * SEQ};
            pg8::gemm_phase<pg8::EpiResid, pg8::StaticOrder, true, true>(ring, g, S, E, F.wave);
            if (l == 0) cvt_steal(F, args, ws, 0, Q_END_B);
        }
        if (l + 1 < DEPTH) SEAM(pb + 6);
    }
#undef IN
#undef SEAM
#undef PK
#undef LOCAL_PTRS
#undef WSP
}

extern "C" void kernel_launch(void* const* d_in, const int* in_sizes, int n_in, void* d_out, int out_size, void* d_ws, size_t ws_size, hipStream_t stream) {
    static int grid = 0;
    if (grid == 0) {
        if (n_in != 20 || in_sizes[0] != SEQ * DM || out_size != SEQ * DM || ws_size < WS_END) {
            fprintf(stderr, "kernel_launch: unexpected shapes: n_in %d in0 %d out %d ws %zu (need %zu); nothing launched\n", n_in, n_in > 0 ? in_sizes[0] : -1, out_size, ws_size, (size_t)WS_END); grid = -1; return; }
        int dev = 0, cus = 0, per_cu = 0;
        if (hipGetDevice(&dev) != hipSuccess || hipDeviceGetAttribute(&cus, hipDeviceAttributeMultiprocessorCount, dev) != hipSuccess) { fprintf(stderr, "kernel_launch: device query failed\n"); grid = -1; return; }
        if (hipFuncSetAttribute((const void*)hybrid_fwd, hipFuncAttributeMaxDynamicSharedMemorySize, LDS_BYTES) != hipSuccess) { fprintf(stderr, "kernel_launch: hipFuncSetAttribute failed\n"); grid = -1; return; }
        if (hipOccupancyMaxActiveBlocksPerMultiprocessor(&per_cu, (const void*)hybrid_fwd, NWAVES * 64, LDS_BYTES) != hipSuccess || per_cu < 1)
            fprintf(stderr, "kernel_launch: note: occupancy query reports %d workgroups per CU\n", per_cu);
        (void)hipGetLastError();
        grid = cus;
    }
    if (grid < 0) return;
    if (hipMemsetAsync((char*)d_ws + WS_CTL, 0, CTL_ZERO_BYTES, stream) != hipSuccess) { fprintf(stderr, "kernel_launch: hipMemsetAsync failed\n"); return; }
    Args a{};
    for (int i = 0; i < 20; ++i) a.in[i] = (const float*)d_in[i];
    a.out = (float*)d_out; a.ws = (unsigned char*)d_ws;
    a.seq = SEQ; a.pad = 0; a.lam_init[0] = 0.2f; a.lam_init[1] = (float)(0.8 - 0.6 * 0.74081822068171786607);
#if MK_PER_PHASE
    for (int p = 0; p < N_PHASES; ++p) { a.ph_lo = p; a.ph_hi = p + 1; hipLaunchKernelGGL(hybrid_fwd, dim3(grid), dim3(NWAVES * 64), LDS_BYTES, stream, a); }
#else
    a.ph_lo = 0; a.ph_hi = N_PHASES;
    hipLaunchKernelGGL(hybrid_fwd, dim3(grid), dim3(NWAVES * 64), LDS_BYTES, stream, a);
#endif
    const hipError_t le = hipPeekAtLastError();
    if (le != hipSuccess) fprintf(stderr, "kernel_launch: launch failed: %s\n", hipGetErrorName(le));
}
```

```cpp
#include <hip/hip_runtime.h>
#include <cstdio>
#include <cstdint>
__device__ __forceinline__ int fresh_lane() { int l; asm volatile("v_mbcnt_lo_u32_b32 %0, -1, 0\n\tv_mbcnt_hi_u32_b32 %0, -1, %0" : "=v"(l)); return l; }
namespace pg8 {
#define PG8_LAS __attribute__((address_space(3)))
typedef unsigned short bf16_t;
typedef short bf16x8 __attribute__((ext_vector_type(8)));
typedef float f32x4 __attribute__((ext_vector_type(4)));
typedef unsigned u32x4 __attribute__((ext_vector_type(4)));
constexpr int BM = 256, BK = 64, HALF = 128, HTB = HALF * BK * 2  , STAGE_BYTES = 8 * HTB, NXCD = 8, WGM = 8;

__host__ __device__ __forceinline__ int lds_byte(int r, int c) { const int st = (r >> 4) * 2 + (c >> 5), rr = r & 15, cc = c & 31, ob = rr * 64 + cc * 2; return st * 1024 + (ob ^ (((ob >> 9) & 1) << 5)); }
__host__ __device__ __forceinline__ void stage_rc(int b, int& R, int& C) { const int st = b / 1024, sb = b % 1024, swz = sb ^ (((sb >> 9) & 1) << 5); R = (st >> 1) * 16 + swz / 64; C = (st & 1) * 32 + (swz % 64) / 2; }
__host__ __device__ __forceinline__ int perm32(int rho) { const int n = rho >> 4, i = rho & 15; return 8 * (i >> 2) + 4 * n + (i & 3); }

__device__ __forceinline__ __amdgpu_buffer_rsrc_t pg8_srd(const void* p, unsigned bytes) {
    const unsigned long long q = (unsigned long long)p;
    const unsigned lo = __builtin_amdgcn_readfirstlane((unsigned)q), hi = __builtin_amdgcn_readfirstlane((unsigned)(q >> 32));
    return __builtin_amdgcn_make_buffer_rsrc((void*)(((unsigned long long)hi << 32) | lo), (short)0, (int)bytes, 0x00020000);
}
struct Unit { int pm, pn; };
struct Gemm { const bf16_t* A; const bf16_t* Bt; int M, N, K; };

#ifndef PG8_ROT
#define PG8_ROT 0
#endif
struct StaticOrder {
    int nM, nN, nwg, G, c;
    __host__ __device__ void init(int M, int N, int G_, int c_) { nM = M / BM; nN = N / BM; nwg = nM * nN; G = G_; c = c_; }
    __host__ __device__ bool next(int i, Unit& u) const {
        const long L = (long)i * G + c; if (L >= nwg) return false;
        int wgid = (int)L; { const int q = nwg / NXCD, r = nwg % NXCD, xcd = wgid % NXCD; int off = wgid / NXCD;
            if (PG8_ROT && r == 0) off = (off + ((xcd >> 1) * 32) % q) % q;
            wgid = (xcd < r ? xcd * (q + 1) : r * (q + 1) + (xcd - r) * q) + off; }
        const int nig = WGM * nN, gid = wgid / nig, fm = gid * WGM, gsz = (nM - fm) < WGM ? (nM - fm) : WGM;
        u.pm = fm + ((wgid % nig) % gsz); u.pn = (wgid % nig) / gsz; return true;
    }
    __device__ __forceinline__ void a_ready(const Unit&) const {}
    __device__ __forceinline__ void done(const Unit&) const {}
};

template <class Epi, class Sched, bool ALIGN_EPI = false, bool SP2 = false>
__device__ __forceinline__ void gemm_phase(PG8_LAS unsigned char* lds, const Gemm g, const Sched& S, const Epi& E, const int wave_  ) {
    int wv_ = wave_; asm volatile("" : "+s"(wv_));
    int tid_ = wv_ * 64 + fresh_lane();
    const int tid = tid_, wid = wv_, lane = tid & 63, wr = wid >> 2, wc = wid & 3, fr = lane & 15, fq = lane >> 4;
    const int K = g.K, nt = K / BK;
    unsigned voffA[2], voffB[2];
#pragma unroll
    for (int i = 0; i < 2; ++i) { int R, C; stage_rc(tid * 16 + i * 8192, R, C); const int Rb = Epi::PERM ? ((R & ~31) + perm32(R & 31)) : R;
        voffA[i] = (unsigned)(R * K + C) * 2u; voffB[i] = (unsigned)(Rb * K + C) * 2u; }
    const unsigned kstep = (unsigned)(BK * 2);
    const unsigned hstep = (unsigned)HALF * (unsigned)K * 2u;
    const unsigned tstep = 2u * hstep;
    const char* base_ = (const char*)g.A < (const char*)g.Bt ? (const char*)g.A : (const char*)g.Bt;
    const unsigned offA = (unsigned)((const char*)g.A - base_), offB = (unsigned)((const char*)g.Bt - base_);
    const __amdgpu_buffer_rsrc_t srdA = pg8_srd(base_, 0xFFFFF000u);
    const unsigned ldsw = (unsigned)wid * 1024u;
    const int aoff = lds_byte(wr * 64 + fr, fq * 8), boff = lds_byte(wc * 32 + fr, fq * 8);
#define PG8_SA(b, h) (((b) * 2 + (h)) * HTB)
#define PG8_SB(b, h) ((4 + (b) * 2 + (h)) * HTB)
#define PG8_STAGE(bufoff, gbase, voff) do { _Pragma("unroll") for (int _i = 0; _i < 2; ++_i) \
        __builtin_amdgcn_raw_ptr_buffer_load_lds(PG8_SRD_OF_##voff, (PG8_LAS void*)(lds + (bufoff) + ldsw + _i * 8192), 16, (int)(voff)[_i], (int)(gbase), 0, 0); } while (0)
#define PG8_SRD_OF_voffA srdA
#define PG8_SRD_OF_voffB srdA
#define PG8_LDA(dst, b, h) do { _Pragma("unroll") for (int m = 0; m < 4; ++m) _Pragma("unroll") for (int k = 0; k < 2; ++k) dst[m][k] = *(const PG8_LAS bf16x8*)(lds + PG8_SA(b, h) + aoff + m * 2048 + k * 1024); } while (0)
#define PG8_LDB(dst, b, h) do { _Pragma("unroll") for (int n = 0; n < 2; ++n) _Pragma("unroll") for (int k = 0; k < 2; ++k) dst[n][k] = *(const PG8_LAS bf16x8*)(lds + PG8_SB(b, h) + boff + n * 2048 + k * 1024); } while (0)
#define PG8_MMA(ai, bj, At, Bt) do { __builtin_amdgcn_s_setprio(1); _Pragma("unroll") for (int m = 0; m < 4; ++m) _Pragma("unroll") for (int n = 0; n < 2; ++n) _Pragma("unroll") for (int k = 0; k < 2; ++k) \
        acc[ai][bj][m][n] = __builtin_amdgcn_mfma_f32_16x16x32_bf16(Bt[n][k], At[m][k], acc[ai][bj][m][n], 0, 0, 0); __builtin_amdgcn_s_setprio(0); } while (0)
#define PG8_WAIT_V(n) asm volatile("s_waitcnt vmcnt(" #n ")" ::: "memory")
#define PG8_WAIT_L(n) asm volatile("s_waitcnt lgkmcnt(" #n ")" ::: "memory")
#define PG8_BAR __builtin_amdgcn_s_barrier()
#define PG8_SCHED __builtin_amdgcn_sched_barrier(0)
    Unit cur, nxt; int ui = 0;
    if (!S.next(0, cur)) return;
    f32x4 acc[2][2][4][2];
#pragma unroll
    for (int a = 0; a < 2; ++a)
#pragma unroll
        for (int b = 0; b < 2; ++b)
#pragma unroll
            for (int m = 0; m < 4; ++m)
#pragma unroll
                for (int n = 0; n < 2; ++n) acc[a][b][m][n] = (f32x4){0.f, 0.f, 0.f, 0.f};
    bf16x8 At[4][2], B0[2][2], B1[2][2];
    unsigned cA = offA + (unsigned)cur.pm * tstep, cB = offB + (unsigned)cur.pn * tstep;
    S.a_ready(cur);
    if constexpr (SP2) {
        PG8_STAGE(PG8_SB(0, 0), cB, voffB); PG8_STAGE(PG8_SB(0, 1), cB + hstep, voffB); PG8_STAGE(PG8_SA(0, 0), cA, voffA); PG8_STAGE(PG8_SA(0, 1), cA + hstep, voffA);
        if (wr == 1) PG8_BAR;
        PG8_WAIT_V(2); PG8_BAR;
        PG8_STAGE(PG8_SB(1, 0), cB + kstep, voffB); PG8_STAGE(PG8_SA(1, 0), cA + kstep, voffA); PG8_STAGE(PG8_SB(1, 1), cB + hstep + kstep, voffB);
        PG8_WAIT_V(6); PG8_BAR;
    } else {
        PG8_STAGE(PG8_SB(0, 0), cB, voffB); PG8_STAGE(PG8_SA(0, 0), cA, voffA); PG8_STAGE(PG8_SB(0, 1), cB + hstep, voffB); PG8_STAGE(PG8_SA(0, 1), cA + hstep, voffA);
        if (wr == 1) PG8_BAR;
        PG8_WAIT_V(4); PG8_BAR;
        PG8_STAGE(PG8_SB(1, 0), cB + kstep, voffB); PG8_STAGE(PG8_SA(1, 0), cA + kstep, voffA); PG8_STAGE(PG8_SB(1, 1), cB + hstep + kstep, voffB);
        PG8_WAIT_V(6); PG8_BAR;
    }
    for (;;) {
        const bool has_next = S.next(ui + 1, nxt);
        const unsigned nA = has_next ? offA + (unsigned)nxt.pm * tstep : cA, nB = has_next ? offB + (unsigned)nxt.pn * tstep : cB;
        for (int t = 0; t < nt; t += 2) {
            const bool last = (t == nt - 2);
            const unsigned a1 = cA + (unsigned)(t + 1) * kstep;
            const unsigned a2 = last ? nA : cA + (unsigned)(t + 2) * kstep, b2 = last ? nB : cB + (unsigned)(t + 2) * kstep;
            const unsigned a3 = a2 + kstep, b3 = b2 + kstep;
            if (last && has_next) S.a_ready(nxt);
            if constexpr (SP2) {
            PG8_LDB(B0, 0, 0); PG8_LDB(B1, 0, 1); PG8_SCHED; PG8_LDA(At, 0, 0); PG8_STAGE(PG8_SA(1, 1), a1 + hstep, voffA);
            PG8_WAIT_V(8); PG8_WAIT_L(0); PG8_BAR; PG8_MMA(0, 0, At, B0); PG8_MMA(0, 1, At, B1); PG8_BAR; PG8_SCHED;
            PG8_LDA(At, 0, 1); PG8_STAGE(PG8_SB(0, 0), b2, voffB); PG8_STAGE(PG8_SB(0, 1), b2 + hstep, voffB); PG8_STAGE(PG8_SA(0, 0), a2, voffA);
            PG8_WAIT_V(8); PG8_WAIT_L(0); PG8_BAR; PG8_MMA(1, 0, At, B0); PG8_MMA(1, 1, At, B1); PG8_BAR; PG8_SCHED;
            PG8_LDB(B0, 1, 0); PG8_LDB(B1, 1, 1); PG8_SCHED; PG8_LDA(At, 1, 0); PG8_STAGE(PG8_SA(0, 1), a2 + hstep, voffA);
            PG8_WAIT_V(8); PG8_WAIT_L(0); PG8_BAR; PG8_MMA(0, 0, At, B0); PG8_MMA(0, 1, At, B1); PG8_BAR; PG8_SCHED;
            PG8_LDA(At, 1, 1); PG8_STAGE(PG8_SB(1, 0), b3, voffB); PG8_STAGE(PG8_SB(1, 1), b3 + hstep, voffB); PG8_STAGE(PG8_SA(1, 0), a3, voffA);
            PG8_WAIT_V(8); PG8_WAIT_L(0); PG8_BAR; PG8_MMA(1, 0, At, B0); PG8_MMA(1, 1, At, B1); PG8_BAR; PG8_SCHED;
            } else {
            PG8_LDB(B0, 0, 0); PG8_SCHED; PG8_LDA(At, 0, 0); PG8_STAGE(PG8_SA(1, 1), a1 + hstep, voffA);
            PG8_WAIT_L(8); PG8_BAR; PG8_WAIT_L(0); PG8_MMA(0, 0, At, B0); PG8_BAR; PG8_SCHED;
            PG8_LDB(B1, 0, 1); PG8_STAGE(PG8_SB(0, 0), b2, voffB);
            PG8_BAR; PG8_WAIT_L(0); PG8_MMA(0, 1, At, B1); PG8_BAR;
            PG8_LDA(At, 0, 1); PG8_STAGE(PG8_SA(0, 0), a2, voffA);
            PG8_BAR; PG8_WAIT_L(0); PG8_MMA(1, 0, At, B0); PG8_BAR; PG8_SCHED;
            PG8_STAGE(PG8_SB(0, 1), b2 + hstep, voffB);
            PG8_WAIT_V(6); PG8_BAR; PG8_MMA(1, 1, At, B1); PG8_BAR;
            PG8_LDB(B0, 1, 0); PG8_SCHED; PG8_LDA(At, 1, 0); PG8_STAGE(PG8_SA(0, 1), a2 + hstep, voffA);
            PG8_WAIT_L(8); PG8_BAR; PG8_WAIT_L(0); PG8_MMA(0, 0, At, B0); PG8_BAR; PG8_SCHED;
            PG8_LDB(B1, 1, 1); PG8_STAGE(PG8_SB(1, 0), b3, voffB);
            PG8_BAR; PG8_WAIT_L(0); PG8_MMA(0, 1, At, B1); PG8_BAR;
            PG8_LDA(At, 1, 1); PG8_STAGE(PG8_SA(1, 0), a3, voffA);
            PG8_BAR; PG8_WAIT_L(0); PG8_MMA(1, 0, At, B0); PG8_BAR; PG8_SCHED;
            PG8_STAGE(PG8_SB(1, 1), b3 + hstep, voffB);
            PG8_WAIT_V(6); PG8_BAR; PG8_MMA(1, 1, At, B1); PG8_BAR;
            }
        }
        if constexpr (ALIGN_EPI) { if (wr == 0) PG8_BAR; }
        if constexpr (!Epi::AFTER_DRAIN) { E(acc, cur, wr, wc, fr, fq); S.done(cur); }
        if (!has_next) break;
#pragma unroll
        for (int a = 0; a < 2; ++a)
#pragma unroll
            for (int b = 0; b < 2; ++b)
#pragma unroll
                for (int m = 0; m < 4; ++m)
#pragma unroll
                    for (int n = 0; n < 2; ++n) acc[a][b][m][n] = (f32x4){0.f, 0.f, 0.f, 0.f};
        cur = nxt; cA = nA; cB = nB; ++ui;
        if constexpr (ALIGN_EPI) { if (wr == 1) PG8_BAR; }
    }
    PG8_WAIT_V(0);
    if constexpr (!ALIGN_EPI) { if (wr == 0) PG8_BAR; }
    PG8_BAR;
    if constexpr (Epi::AFTER_DRAIN) { E.fused(acc, cur, wr, wc, fr, fq, lds, wid, lane); S.done(cur); }
#undef PG8_SA
#undef PG8_SB
#undef PG8_STAGE
#undef PG8_LDA
#undef PG8_LDB
#undef PG8_MMA
#undef PG8_WAIT_V
#undef PG8_WAIT_L
#undef PG8_BAR
#undef PG8_SCHED
}
}
namespace pg8 {
constexpr float RMS_EPS = 1e-6f;
__device__ __forceinline__ unsigned cvt_pk_bf16(float lo, float hi) { unsigned r; asm volatile("v_cvt_pk_bf16_f32 %0, %1, %2" : "=v"(r) : "v"(lo), "v"(hi)); return r; }
__device__ __forceinline__ u32x4 pack8(const f32x4 a, const f32x4 b) { u32x4 w; w.x = cvt_pk_bf16(a[0], a[1]); w.y = cvt_pk_bf16(a[2], a[3]); w.z = cvt_pk_bf16(b[0], b[1]); w.w = cvt_pk_bf16(b[2], b[3]); return w; }
__device__ __forceinline__ float dot4(const f32x4 a) { return (a[0] * a[0] + a[1] * a[1]) + (a[2] * a[2] + a[3] * a[3]); }
__device__ __forceinline__ float fq_sum(float s) { s += __shfl_xor(s, 16); s += __shfl_xor(s, 32); return s; }
#define PG8_EPI_BAR() do { asm volatile("s_waitcnt lgkmcnt(0)" ::: "memory"); __builtin_amdgcn_s_barrier(); asm volatile("" ::: "memory"); } while (0)
typedef float f32x4a __attribute__((ext_vector_type(4)));

struct EpiInProj {
    static constexpr bool PERM = true, AFTER_DRAIN = false;
    bf16_t *QA, *KA, *VA, *QB, *KB, *VB, *CQL, *CKVL; float* CKR; float *SSQ_Q, *SSQ_KV, *SSQ_KR;
    const float *gaq, *gak, *gbq, *gbk;
    const float *tcC, *tsC, *tcB, *tsB;
    PG8_LAS float* P;
    const float* SSQ_H;
    __device__ __forceinline__ float row_rs(int t) const { return rsqrtf(SSQ_H[t] * (1.0f / 4096.0f) + RMS_EPS); }
    __device__ __forceinline__ void plain(const f32x4 (&acc)[2][2][4][2], int row0, int wc, int fq, bf16_t* dst, int ld) const {
#pragma unroll
        for (int ai = 0; ai < 2; ++ai)
#pragma unroll
            for (int m = 0; m < 4; ++m) { const int t = row0 + ai * HALF + m * 16; const float rs = row_rs(t); bf16_t* rowp = dst + (size_t)t * ld + wc * 32 + 8 * fq;
#pragma unroll
                for (int bj = 0; bj < 2; ++bj) *(u32x4*)(rowp + bj * HALF) = pack8(acc[ai][bj][m][0] * rs, acc[ai][bj][m][1] * rs); }
    }
    __device__ __forceinline__ void row_ssq(const f32x4 (&acc)[2][2][4][2], int row0, int fq, float* ssq, bool both) const {
#pragma unroll
        for (int ai = 0; ai < 2; ++ai)
#pragma unroll
            for (int m = 0; m < 4; ++m) { float s = dot4(acc[ai][0][m][0]) + dot4(acc[ai][0][m][1]); if (both) s += dot4(acc[ai][1][m][0]) + dot4(acc[ai][1][m][1]);
                s = fq_sum(s); const int t = row0 + ai * HALF + m * 16; const float rs = row_rs(t); if (fq == 0) __hip_atomic_fetch_add(ssq + t, s * rs * rs, __ATOMIC_RELAXED, __HIP_MEMORY_SCOPE_AGENT); }
    }
    __device__ __forceinline__ void partials(const f32x4 (&acc)[2][2][4][2], int wr, int wc, int fr, int fq) const {
#pragma unroll
        for (int ai = 0; ai < 2; ++ai)
#pragma unroll
            for (int m = 0; m < 4; ++m)
#pragma unroll
                for (int bj = 0; bj < 2; ++bj) { float s = dot4(acc[ai][bj][m][0]) + dot4(acc[ai][bj][m][1]); s = fq_sum(s);
                    if (fq == 0) P[(ai * HALF + wr * 64 + m * 16 + fr) * 8 + bj * 4 + wc] = s; }
    }
    __device__ __forceinline__ void operator()(const f32x4 (&acc)[2][2][4][2], const Unit& u, int wr, int wc, int fr_, int fq_) const {
        int fr = fr_, fq = fq_; asm volatile("" : "+v"(fr), "+v"(fq));
        const int pn = u.pn, row0 = u.pm * BM + wr * 64 + fr;
        if (pn < 8) {
            bf16_t* dst = pn < 6 ? QA + pn * 256 : KA + (pn - 6) * 256; const int ld = pn < 6 ? 1536 : 512; const float* gain = pn < 6 ? gaq : gak;
            const float qs = pn < 6 ? 0.088388347648318440f * 1.4426950408889634f : 1.0f;
            partials(acc, wr, wc, fr, fq); PG8_EPI_BAR();
            const int hh = wc >> 1, i0 = (wc & 1) * 16 + fq * 4;
            const f32x4 g1 = *(const f32x4*)(gain + hh * 64 + i0), g2 = *(const f32x4*)(gain + hh * 64 + 32 + i0);
#pragma unroll
            for (int ai = 0; ai < 2; ++ai)
#pragma unroll
                for (int m = 0; m < 4; ++m) { const int rl = ai * HALF + wr * 64 + m * 16 + fr, t = u.pm * BM + rl;
                    const f32x4 pa = *(const PG8_LAS f32x4*)(P + rl * 8), pb = *(const PG8_LAS f32x4*)(P + rl * 8 + 4);
                    const float rs = row_rs(t), rs2 = rs * rs * (1.0f / 128.0f);
                    const float r0 = qs * rs * rsqrtf(((pa[0] + pa[1]) + (pa[2] + pa[3])) * rs2 + RMS_EPS), r1 = qs * rs * rsqrtf(((pb[0] + pb[1]) + (pb[2] + pb[3])) * rs2 + RMS_EPS);
                    const int pos = hh ? (t & 63) : (t >> 6);
                    const f32x4 c = *(const f32x4*)(tcC + pos * 32 + i0), s = *(const f32x4*)(tsC + pos * 32 + i0);
                    bf16_t* rowp = dst + (size_t)t * ld + wc * 32 + 8 * fq;
#pragma unroll
                    for (int bj = 0; bj < 2; ++bj) { const float r = bj ? r1 : r0; const f32x4 a = acc[ai][bj][m][0] * r * g1, b = acc[ai][bj][m][1] * r * g2;
                        *(u32x4*)(rowp + bj * HALF) = pack8(a * c - b * s, b * c + a * s); }
                    }
        } else if (pn < 10) { plain(acc, row0, wc, fq, VA + (pn - 8) * 256, 512);
        } else if (pn < 18) {
            bf16_t* dst = pn < 14 ? QB + (pn - 10) * 256 : KB + (pn - 14) * 256; const float* gain = pn < 14 ? gbq : gbk;
            const float qs = pn < 14 ? 0.125f * 1.4426950408889634f : 1.0f;
            partials(acc, wr, wc, fr, fq); PG8_EPI_BAR();
            const bool rope = ((wc & 1) == 0) && (fq < 2);
            const int l1 = rope ? fq * 4 : (wc & 1) * 32 + fq * 8, l2 = rope ? 8 + fq * 4 : (wc & 1) * 32 + fq * 8 + 4;
            const f32x4 g1 = *(const f32x4*)(gain + l1), g2 = *(const f32x4*)(gain + l2);
            const int sub = (wc >> 1) * 2;
#pragma unroll
            for (int ai = 0; ai < 2; ++ai)
#pragma unroll
                for (int m = 0; m < 4; ++m) { const int rl = ai * HALF + wr * 64 + m * 16 + fr, t = u.pm * BM + rl;
                    const float rs = row_rs(t), rs2 = rs * rs * (1.0f / 64.0f);
                    const float r0 = qs * rs * rsqrtf((P[rl * 8 + sub] + P[rl * 8 + sub + 1]) * rs2 + RMS_EPS), r1 = qs * rs * rsqrtf((P[rl * 8 + 4 + sub] + P[rl * 8 + 4 + sub + 1]) * rs2 + RMS_EPS);
                    f32x4 c = (f32x4){1.f, 1.f, 1.f, 1.f}, s = (f32x4){0.f, 0.f, 0.f, 0.f};
                    if (rope) { c = *(const f32x4*)(tcB + t * 8 + fq * 4); s = *(const f32x4*)(tsB + t * 8 + fq * 4); }
                    bf16_t* rowp = dst + (size_t)t * 1024 + wc * 32 + 8 * fq;
#pragma unroll
                    for (int bj = 0; bj < 2; ++bj) { const float r = bj ? r1 : r0; const f32x4 a = acc[ai][bj][m][0] * r * g1, b = acc[ai][bj][m][1] * r * g2;
                        *(u32x4*)(rowp + bj * HALF) = pack8(a * c - b * s, b * c + a * s); }
                    }
        } else if (pn < 22) { plain(acc, row0, wc, fq, VB + (pn - 18) * 256, 1024);
        } else if (pn < 26) { plain(acc, row0, wc, fq, CQL + (pn - 22) * 256, 1024); row_ssq(acc, row0, fq, SSQ_Q, true);
        } else if (pn < 28) { plain(acc, row0, wc, fq, CKVL + (pn - 26) * 256, 512); row_ssq(acc, row0, fq, SSQ_KV, true);
        } else {
            if (wc < 2) {
#pragma unroll
                for (int ai = 0; ai < 2; ++ai)
#pragma unroll
                    for (int m = 0; m < 4; ++m) { const int t = row0 + ai * HALF + m * 16; const float rs = row_rs(t); float* rowp = CKR + (size_t)t * 64 + wc * 32 + 8 * fq;
                        *(f32x4*)rowp = acc[ai][0][m][0] * rs; *(f32x4*)(rowp + 4) = acc[ai][0][m][1] * rs; }
                row_ssq(acc, row0, fq, SSQ_KR, false);
            }
        }
    }
};

struct EpiQUp {
    static constexpr bool PERM = true, AFTER_DRAIN = false;
    bf16_t* QC; const float* SSQ_Q; const float* gq; const float *tcC, *tsC; PG8_LAS float* P;
    __device__ __forceinline__ void operator()(const f32x4 (&acc)[2][2][4][2], const Unit& u, int wr, int wc, int fr_, int fq_) const {
        int fr = fr_, fq = fq_; asm volatile("" : "+v"(fr), "+v"(fq));
#pragma unroll
        for (int ai = 0; ai < 2; ++ai)
#pragma unroll
            for (int m = 0; m < 4; ++m)
#pragma unroll
                for (int bj = 0; bj < 2; ++bj) { float s = dot4(acc[ai][bj][m][0]) + dot4(acc[ai][bj][m][1]); s = fq_sum(s);
                    if (fq == 0) P[(ai * HALF + wr * 64 + m * 16 + fr) * 8 + bj * 4 + wc] = s; }
        PG8_EPI_BAR();
        const int h = u.pn, cn = wc * 32 + 8 * fq, i0 = (wc & 1) * 16 + fq * 4;
        const f32x4 gn1 = *(const f32x4*)(gq + cn), gn2 = *(const f32x4*)(gq + cn + 4);
        const f32x4 gr1 = *(const f32x4*)(gq + 128 + i0), gr2 = *(const f32x4*)(gq + 160 + i0);
#pragma unroll
        for (int ai = 0; ai < 2; ++ai)
#pragma unroll
            for (int m = 0; m < 4; ++m) { const int rl = ai * HALF + wr * 64 + m * 16 + fr, t = u.pm * BM + rl;
                const f32x4 pa = *(const PG8_LAS f32x4*)(P + rl * 8); const float pb0 = P[rl * 8 + 4], pb1 = P[rl * 8 + 5];
                const float rs = rsqrtf(SSQ_Q[t] * (1.0f / 1024.0f) + RMS_EPS);
                const float tot = (((pa[0] + pa[1]) + (pa[2] + pa[3])) + (pb0 + pb1)) * rs * rs;
                const float f = rs * rsqrtf(tot * (1.0f / 192.0f) + RMS_EPS) * (0.072168783648703220f * 1.4426950408889634f);
                bf16_t* rowp = QC + (size_t)t * 2304 + h * 192;
                *(u32x4*)(rowp + cn) = pack8(acc[ai][0][m][0] * f * gn1, acc[ai][0][m][1] * f * gn2);
                if (wc < 2) { const f32x4 c = *(const f32x4*)(tcC + t * 32 + i0), s = *(const f32x4*)(tsC + t * 32 + i0);
                    const f32x4 a = acc[ai][1][m][0] * f * gr1, b = acc[ai][1][m][1] * f * gr2;
                    *(u32x4*)(rowp + 128 + cn) = pack8(a * c - b * s, b * c + a * s); }
                }
    }
};

struct EpiKVUp {
    static constexpr bool PERM = true, AFTER_DRAIN = false;
    bf16_t *KC, *VC; const float *SSQ_KV, *SSQ_KR, *CKR; const float* gk; const float *tcC, *tsC; PG8_LAS float* P;
    __device__ __forceinline__ void operator()(const f32x4 (&acc)[2][2][4][2], const Unit& u, int wr, int wc, int fr_, int fq_) const {
        int fr = fr_, fq = fq_; asm volatile("" : "+v"(fr), "+v"(fq));
#pragma unroll
        for (int ai = 0; ai < 2; ++ai)
#pragma unroll
            for (int m = 0; m < 4; ++m) { float s = dot4(acc[ai][0][m][0]) + dot4(acc[ai][0][m][1]); s = fq_sum(s);
                if (fq == 0) P[(ai * HALF + wr * 64 + m * 16 + fr) * 8 + wc] = s; }
        PG8_EPI_BAR();
        const int h = u.pn, cn = wc * 32 + 8 * fq;
        const f32x4 gn1 = *(const f32x4*)(gk + cn), gn2 = *(const f32x4*)(gk + cn + 4);
#pragma unroll
        for (int ai = 0; ai < 2; ++ai)
#pragma unroll
            for (int m = 0; m < 4; ++m) { const int rl = ai * HALF + wr * 64 + m * 16 + fr, t = u.pm * BM + rl;
                const f32x4 pa = *(const PG8_LAS f32x4*)(P + rl * 8);
                const float rs = rsqrtf(SSQ_KV[t] * (1.0f / 512.0f) + RMS_EPS);
                const float tot = ((pa[0] + pa[1]) + (pa[2] + pa[3])) * rs * rs + SSQ_KR[t];
                const float rk = rsqrtf(tot * (1.0f / 192.0f) + RMS_EPS), f = rs * rk;
                *(u32x4*)(KC + (size_t)t * 2304 + h * 192 + cn) = pack8(acc[ai][0][m][0] * f * gn1, acc[ai][0][m][1] * f * gn2);
                *(u32x4*)(VC + (size_t)t * 1536 + h * 128 + cn) = pack8(acc[ai][1][m][0] * rs, acc[ai][1][m][1] * rs);
                if (wc == 0 && fq == 0) P[2048 + rl] = rk;
                }
        PG8_EPI_BAR();
        const int tid = (wr * 4 + wc) * 64 + fresh_lane();
#pragma unroll
        for (int k = 0; k < 4; ++k) { const int id = tid + 512 * k, rl = id >> 3, c8 = id & 7, i0 = (c8 >> 2) * 16 + (c8 & 3) * 4, t = u.pm * BM + rl;
            const float rk = P[2048 + rl];
            const f32x4 x1 = *(const f32x4*)(CKR + (size_t)t * 64 + i0), x2 = *(const f32x4*)(CKR + (size_t)t * 64 + 32 + i0);
            const f32x4 g1 = *(const f32x4*)(gk + 128 + i0), g2 = *(const f32x4*)(gk + 160 + i0);
            const f32x4 c = *(const f32x4*)(tcC + t * 32 + i0), s = *(const f32x4*)(tsC + t * 32 + i0);
            const f32x4 a = x1 * rk * g1, b = x2 * rk * g2;
            *(u32x4*)(KC + (size_t)t * 2304 + h * 192 + 128 + 8 * c8) = pack8(a * c - b * s, b * c + a * s);
            }
    }
};

struct EpiResid {
    static constexpr bool PERM = true, AFTER_DRAIN = false;
    bf16_t* hb; float* out; int ldc; float* ssq;
    __device__ __forceinline__ void operator()(const f32x4 (&acc)[2][2][4][2], const Unit& u, int wr, int wc, int fr_, int fq_) const {
        int fr = fr_, fq = fq_; asm volatile("" : "+v"(fr), "+v"(fq));
        const int col0 = u.pn * BM + wc * 32 + 8 * fq;
#pragma unroll
        for (int ai = 0; ai < 2; ++ai)
#pragma unroll
            for (int m = 0; m < 4; ++m) { const size_t off = (size_t)(u.pm * BM + ai * HALF + wr * 64 + m * 16 + fr) * ldc + col0; float s = 0.f;
#pragma unroll
                for (int bj = 0; bj < 2; ++bj) { const u32x4 b = *(const u32x4*)(hb + off + bj * HALF);
                    const f32x4 o0 = (f32x4){__uint_as_float(b.x << 16), __uint_as_float(b.x & 0xffff0000u), __uint_as_float(b.y << 16), __uint_as_float(b.y & 0xffff0000u)} + acc[ai][bj][m][0];
                    const f32x4 o1 = (f32x4){__uint_as_float(b.z << 16), __uint_as_float(b.z & 0xffff0000u), __uint_as_float(b.w << 16), __uint_as_float(b.w & 0xffff0000u)} + acc[ai][bj][m][1];
                    if (out) { *(f32x4*)(out + off + bj * HALF) = o0; *(f32x4*)(out + off + bj * HALF + 4) = o1; }
                    else { *(u32x4*)(hb + off + bj * HALF) = pack8(o0, o1); s += dot4(o0) + dot4(o1); } }
                if (!out) { s = fq_sum(s); if (fq == 0) __hip_atomic_fetch_add(ssq + u.pm * BM + ai * HALF + wr * 64 + m * 16 + fr, s, __ATOMIC_RELAXED, __HIP_MEMORY_SCOPE_AGENT); } }
    }
};

struct EpiGateUp {
    static constexpr bool PERM = true, AFTER_DRAIN = false;
    bf16_t* ACT; int ldc; const float* SSQ_H;
    __device__ __forceinline__ void operator()(const f32x4 (&acc)[2][2][4][2], const Unit& u, int wr, int wc, int fr_, int fq_) const {
        int fr = fr_, fq = fq_; asm volatile("" : "+v"(fr), "+v"(fq));
        const int col0 = u.pn * HALF + wc * 32 + 8 * fq;
        float q8[2][4];
#pragma unroll
        for (int ai = 0; ai < 2; ++ai)
#pragma unroll
            for (int m = 0; m < 4; ++m) q8[ai][m] = SSQ_H[u.pm * BM + ai * HALF + wr * 64 + m * 16 + fr];
        asm volatile("" : "+v"(q8[0][0]), "+v"(q8[0][1]), "+v"(q8[0][2]), "+v"(q8[0][3]), "+v"(q8[1][0]), "+v"(q8[1][1]), "+v"(q8[1][2]), "+v"(q8[1][3]));
#pragma unroll
        for (int ai = 0; ai < 2; ++ai)
#pragma unroll
            for (int m = 0; m < 4; ++m) { f32x4 o[2]; const float rs = rsqrtf(q8[ai][m] * (1.0f / 4096.0f) + RMS_EPS);
#pragma unroll
                for (int n = 0; n < 2; ++n) { const f32x4 g = acc[ai][0][m][n] * rs, up = acc[ai][1][m][n] * rs;
#pragma unroll
                    for (int j = 0; j < 4; ++j) { const float e = __builtin_amdgcn_exp2f(g[j] * -1.4426950408889634f); o[n][j] = g[j] * __builtin_amdgcn_rcpf(1.0f + e) * up[j]; } }
                *(u32x4*)(ACT + (size_t)(u.pm * BM + ai * HALF + wr * 64 + m * 16 + fr) * ldc + col0) = pack8(o[0], o[1]); }
    }
};
}
namespace att {
typedef unsigned short bf16_t;
using bf16x8 = __attribute__((ext_vector_type(8))) short;
using s16x4  = __attribute__((ext_vector_type(4))) short;
using f32x16 = __attribute__((ext_vector_type(16))) float;
using u32x4  = __attribute__((ext_vector_type(4))) unsigned;
constexpr int NW = 8, QBLK = 32, KVBLK = 64;
constexpr int SHM_V = KVBLK * 128 * 2;
template <int NKS> struct KCfg { static constexpr int DQK = NKS * 16, KROW = DQK * 2 + 16, SHM_K = KVBLK * KROW, CPR = DQK / 8, NCH = DQK / 64; };
template <int NKS, int QL, int NSLOT = 2> constexpr int lds_bytes() { return NSLOT * SHM_V + NSLOT * KCfg<NKS>::SHM_K + NW * 64 * 4 + (QL ? NW * 32 * (QL * 32 + 16) : 0); }
#define SBAR() __builtin_amdgcn_sched_barrier(0)
typedef unsigned v4u32_t __attribute__((ext_vector_type(4)));
__device__ __forceinline__ __amdgpu_buffer_rsrc_t make_srd(const void* p, unsigned bytes) {
  const unsigned long long q = (unsigned long long)p;
  const unsigned lo = __builtin_amdgcn_readfirstlane((unsigned)q), hi = __builtin_amdgcn_readfirstlane((unsigned)(q >> 32));
  return __builtin_amdgcn_make_buffer_rsrc((void*)(((unsigned long long)hi << 32) | lo), (short)0, (int)bytes, 0x00020000);
}
__device__ __forceinline__ bf16x8 buf_ld16(__amdgpu_buffer_rsrc_t srd, unsigned voff, unsigned soff) {
  const v4u32_t v = __builtin_amdgcn_raw_buffer_load_b128(srd, (int)voff, (int)soff, 0); return __builtin_bit_cast(bf16x8, v);
}
__device__ __forceinline__ int crow(int r, int hi) { return (r & 3) + 8 * (r >> 2) + 4 * hi; }
__device__ __forceinline__ unsigned cvtpk(float lo, float hi) { unsigned r; asm volatile("v_cvt_pk_bf16_f32 %0, %1, %2" : "=v"(r) : "v"(lo), "v"(hi)); return r; }
#ifndef ATT_PROBE
#define ATT_PROBE 0
#endif
#ifndef ATT_HANDSCHED
#define ATT_HANDSCHED 1
#endif
constexpr bool HANDSCHED = ATT_HANDSCHED != 0;
constexpr float THR = 8.f, THRL = THR * 1.4426950408889634f;

__device__ __forceinline__ float max3f(float a, float b, float c) { float r; asm("v_max3_f32 %0, %1, %2, %3" : "=v"(r) : "v"(a), "v"(b), "v"(c)); return r; }
__device__ __forceinline__ float max2f(float a, float b) { float r; asm("v_max_f32_e32 %0, %1, %2" : "=v"(r) : "v"(a), "v"(b)); return r; }
template <bool BND = false> __device__ __forceinline__ void partialSM(f32x16& p0, f32x16& p1, float& m_ref, f32x16& negm, float& alpha, const float THRL) {
  if constexpr (BND) { alpha = 1.f;
#pragma unroll
    for (int r = 0; r < 16; ++r) p0[r] = __builtin_amdgcn_exp2f(p0[r]);
    return; }
  float a = max3f(p0[0], p0[1], p1[0]), b = max3f(p0[2], p0[3], p1[1]); a = max3f(a, p1[2], p1[3]);
#pragma unroll
  for (int r = 4; r < 16; r += 4) { a = max3f(a, p0[r], p0[r + 1]); b = max3f(b, p0[r + 2], p0[r + 3]); a = max3f(a, p1[r], p1[r + 1]); b = max3f(b, p1[r + 2], p1[r + 3]); }
  float rm = max2f(a, b);
  { auto rr = __builtin_amdgcn_permlane32_swap(__float_as_uint(rm), __float_as_uint(rm), false, false);
    rm = max2f(__uint_as_float(rr[0]), __uint_as_float(rr[1])); }
  alpha = 1.f;
  if (__builtin_expect(__any(rm > THRL), 0)) {
    const float dl = fmaxf(rm, 0.f);
#pragma unroll
    for (int r = 0; r < 16; ++r) { p0[r] -= dl; p1[r] -= dl; }
#pragma unroll
    for (int r = 0; r < 16; ++r) negm[r] -= dl;
    alpha = __builtin_amdgcn_exp2f(-dl);
  }
#pragma unroll
  for (int r = 0; r < 16; ++r) p0[r] = __builtin_amdgcn_exp2f(p0[r]);
}
template <bool EXP1 = true> __device__ __forceinline__ void finishSM(f32x16& p0, f32x16& p1, float alpha, float& l_reg, bf16x8& pa0, bf16x8& pa1, bf16x8& pa2, bf16x8& pa3) {
  if constexpr (EXP1) {
#pragma unroll
  for (int r = 0; r < 16; ++r) p1[r] = __builtin_amdgcn_exp2f(p1[r]); }
  float ps = 0;
  if (ATT_PROBE == 1) { float junk = 0.f;
#pragma unroll
    for (int r = 0; r < 16; ++r) { float t0 = p0[r], t1 = p1[r]; asm volatile("v_exp_f32 %0, %0\n\tv_exp_f32 %1, %1" : "+v"(t0), "+v"(t1)); junk += t0 + t1; }
    asm volatile("" :: "v"(junk)); }
#pragma unroll
  for (int r = 0; r < 16; ++r) ps += p0[r];
#pragma unroll
  for (int r = 0; r < 16; ++r) ps += p1[r];
  { auto rr = __builtin_amdgcn_permlane32_swap(__float_as_uint(ps), __float_as_uint(ps), false, false);
    ps = __uint_as_float(rr[0]) + __uint_as_float(rr[1]); }
  l_reg = l_reg * alpha + ps;
#define PK4(P, BASE, OUT) do { unsigned a0 = cvtpk(P[BASE + 0], P[BASE + 1]), a1 = cvtpk(P[BASE + 2], P[BASE + 3]);   \
    unsigned b0 = cvtpk(P[BASE + 4], P[BASE + 5]), b1 = cvtpk(P[BASE + 6], P[BASE + 7]);                              \
    u32x4 w = {a0, a1, b0, b1}; OUT = *reinterpret_cast<bf16x8*>(&w); } while (0)
  PK4(p0, 0, pa0); PK4(p0, 8, pa1); PK4(p1, 0, pa2); PK4(p1, 8, pa3);
#undef PK4
}
template <int NKS, int QL> __device__ __forceinline__ void qkt(f32x16& p0, f32x16& p1, const char* Ks, const bf16x8* qr, const char* ql, const f32x16& negm, int r32, int hi) {
  constexpr int KROW = KCfg<NKS>::KROW;
#pragma unroll
  for (int d0 = 0; d0 < NKS; ++d0) { const int cb = (d0 * 16 + hi * 8) * 2;
    const bf16x8 b0 = *reinterpret_cast<const bf16x8*>(Ks + r32 * KROW + cb);
    const bf16x8 b1 = *reinterpret_cast<const bf16x8*>(Ks + (32 + r32) * KROW + cb);
    if (ATT_PROBE == 2) { bf16x8 x0 = *reinterpret_cast<const volatile bf16x8*>(Ks + r32 * KROW + cb), x1 = *reinterpret_cast<const volatile bf16x8*>(Ks + (32 + r32) * KROW + cb); asm volatile("" :: "v"(x0), "v"(x1)); }
    bf16x8 q; if constexpr (QL > 0) { if (d0 >= NKS - QL) q = *reinterpret_cast<const bf16x8*>(ql + (d0 - (NKS - QL)) * 32); else q = qr[d0]; } else q = qr[d0];
    if (d0 == 0) { p0 = __builtin_amdgcn_mfma_f32_32x32x16_bf16(b0, q, negm, 0, 0, 0); p1 = __builtin_amdgcn_mfma_f32_32x32x16_bf16(b1, q, negm, 0, 0, 0); }
    else { p0 = __builtin_amdgcn_mfma_f32_32x32x16_bf16(b0, q, p0, 0, 0, 0); p1 = __builtin_amdgcn_mfma_f32_32x32x16_bf16(b1, q, p1, 0, 0, 0); } }
}
__device__ __forceinline__ int v_st(int k, int c) { const int kk = k; return ((kk >> 3) * 4 + (c >> 5)) * 512 + ((kk & 7) * 32 + (c & 31)) * 2; }
__device__ __forceinline__ int v_rd_base(int lane) { return ((lane & 3) << 3) | (((lane >> 2) & 3) << 6) | (((lane >> 4) & 1) << 5) | (((lane >> 5) & 1) << 8); }
constexpr int v_rd_off(int d0, int ks, int half) { return d0 * 512 + ks * 4096 + half * 2048; }
typedef short v4i16_t __attribute__((ext_vector_type(4)));
template <int OFF> __device__ __forceinline__ s16x4 tr_read(int vb) {
  return __builtin_bit_cast(s16x4, __builtin_amdgcn_ds_read_tr16_b64_v4i16((__attribute__((address_space(3))) v4i16_t*)(uintptr_t)(unsigned)(vb + OFF)));
}
struct VFrag { s16x4 l0, h0, l1, h1, l2, h2, l3, h3; };
template <int D0> __device__ __forceinline__ void v_read8(VFrag& f, int vb) {
  f.l0 = tr_read<v_rd_off(D0, 0, 0)>(vb); f.h0 = tr_read<v_rd_off(D0, 0, 1)>(vb); f.l1 = tr_read<v_rd_off(D0, 1, 0)>(vb); f.h1 = tr_read<v_rd_off(D0, 1, 1)>(vb);
  f.l2 = tr_read<v_rd_off(D0, 2, 0)>(vb); f.h2 = tr_read<v_rd_off(D0, 2, 1)>(vb); f.l3 = tr_read<v_rd_off(D0, 3, 0)>(vb); f.h3 = tr_read<v_rd_off(D0, 3, 1)>(vb);
}
__device__ __forceinline__ void pv_mma4(f32x16& od, const VFrag& f, bf16x8 pa0, bf16x8 pa1, bf16x8 pa2, bf16x8 pa3) {
#define PK(L, H) (bf16x8){L[0], L[1], L[2], L[3], H[0], H[1], H[2], H[3]}
  od = __builtin_amdgcn_mfma_f32_32x32x16_bf16(pa0, PK(f.l0, f.h0), od, 0, 0, 0);
  od = __builtin_amdgcn_mfma_f32_32x32x16_bf16(pa1, PK(f.l1, f.h1), od, 0, 0, 0);
  od = __builtin_amdgcn_mfma_f32_32x32x16_bf16(pa2, PK(f.l2, f.h2), od, 0, 0, 0);
  od = __builtin_amdgcn_mfma_f32_32x32x16_bf16(pa3, PK(f.l3, f.h3), od, 0, 0, 0);
#undef PK
}
#define PV_WAIT(N) SBAR()
__device__ __forceinline__ void pv_d0(f32x16* o, int vb, bf16x8 pa0, bf16x8 pa1, bf16x8 pa2, bf16x8 pa3) {
  VFrag fa, fb;
  SBAR(); v_read8<0>(fa, vb); v_read8<1>(fb, vb); PV_WAIT(8);
  pv_mma4(o[0], fa, pa0, pa1, pa2, pa3); SBAR();
  v_read8<2>(fa, vb); PV_WAIT(8);
  pv_mma4(o[1], fb, pa0, pa1, pa2, pa3); SBAR();
  v_read8<3>(fb, vb); PV_WAIT(8);
  pv_mma4(o[2], fa, pa0, pa1, pa2, pa3); PV_WAIT(0);
  pv_mma4(o[3], fb, pa0, pa1, pa2, pa3);
}

#define MX3(a, b, c) __builtin_fmaxf(__builtin_fmaxf((a), (b)), (c))
template <int S> __device__ __forceinline__ void fin_slot(f32x16& p0, f32x16& p1, float& sacc, unsigned (&cv)[16], u32x4 (&w)[4]) {
  if constexpr (S < 16) sacc += p0[S];
  else if constexpr (S >= 28 && S < 44) sacc += p1[S - 28];
  else { constexpr bool second = S >= 44; constexpr int k = second ? S - 44 : S - 16, grp = k / 6, idx = k % 6, t = (second ? 2 : 0) + grp, cb = 4 * t;
    if constexpr (idx < 4) { constexpr int e = 2 * (grp * 4 + idx); cv[cb + idx] = second ? cvtpk(p1[e], p1[e + 1]) : cvtpk(p0[e], p0[e + 1]); }
    else if constexpr (idx == 4) { w[t].x = cv[cb]; w[t].y = cv[cb + 1]; }
    else { w[t].z = cv[cb + 2]; w[t].w = cv[cb + 3]; } }
}
template <int S0, int S1> __device__ __forceinline__ void fin_slots(f32x16& p0, f32x16& p1, float& sacc, unsigned (&cv)[16], u32x4 (&w)[4]) {
  if constexpr (S0 < S1) { fin_slot<S0>(p0, p1, sacc, cv, w); fin_slots<S0 + 1, S1>(p0, p1, sacc, cv, w); }
}
template <int NM, int G> constexpr int fin_bound() { return (56 * G) / NM; }
template <int NKS, int D0> __device__ __forceinline__ void r1_steps(f32x16& X0, f32x16& X1, const char* kp, const bf16x8* qr, const f32x16& negm, f32x16& Y0, f32x16& Y1, float& sacc,
                                                                   unsigned (&cv)[16], u32x4 (&w)[4], bf16x8& ka0, bf16x8& ka1, bf16x8& kb0, bf16x8& kb1) {
  if constexpr (D0 < NKS) { constexpr int KROW = KCfg<NKS>::KROW, NM = 2 * NKS;
    bf16x8& k0 = (D0 & 1) ? kb0 : ka0; bf16x8& k1 = (D0 & 1) ? kb1 : ka1;
    if constexpr (D0 == 0) X0 = __builtin_amdgcn_mfma_f32_32x32x16_bf16(k0, qr[D0], negm, 0, 0, 0); else X0 = __builtin_amdgcn_mfma_f32_32x32x16_bf16(k0, qr[D0], X0, 0, 0, 0);
    if constexpr (ATT_PROBE == 4 && NKS == 4) { f32x16 dm_ = negm; dm_ = __builtin_amdgcn_mfma_f32_32x32x16_bf16(k1, qr[D0], dm_, 0, 0, 0); asm volatile("" :: "v"(dm_)); }
    if constexpr (ATT_PROBE == 5 && NKS == 4) { bf16x8 x0_ = *reinterpret_cast<const volatile bf16x8*>(kp + D0 * 32), x1_ = *reinterpret_cast<const volatile bf16x8*>(kp + 32 * KROW + D0 * 32); asm volatile("" :: "v"(x0_), "v"(x1_)); }
    fin_slots<fin_bound<NM, 2 * D0>(), fin_bound<NM, 2 * D0 + 1>()>(Y0, Y1, sacc, cv, w);
    if (ATT_PROBE == 3) { float t_ = sacc; asm volatile("v_exp_f32 %0, %0" : "+v"(t_)); asm volatile("" :: "v"(t_)); }
    SBAR();
    if constexpr (D0 == 0) X1 = __builtin_amdgcn_mfma_f32_32x32x16_bf16(k1, qr[D0], negm, 0, 0, 0); else X1 = __builtin_amdgcn_mfma_f32_32x32x16_bf16(k1, qr[D0], X1, 0, 0, 0);
    if constexpr (D0 + 2 < NKS) { k0 = *reinterpret_cast<const bf16x8*>(kp + (D0 + 2) * 32); k1 = *reinterpret_cast<const bf16x8*>(kp + 32 * KROW + (D0 + 2) * 32); }
    fin_slots<fin_bound<NM, 2 * D0 + 1>(), fin_bound<NM, 2 * D0 + 2>()>(Y0, Y1, sacc, cv, w);
    if (ATT_PROBE == 3) { float t_ = sacc; asm volatile("v_exp_f32 %0, %0" : "+v"(t_)); asm volatile("" :: "v"(t_)); }
    SBAR();
    r1_steps<NKS, D0 + 1>(X0, X1, kp, qr, negm, Y0, Y1, sacc, cv, w, ka0, ka1, kb0, kb1); }
}
template <int NKS> __device__ __forceinline__ void region1(f32x16& X0, f32x16& X1, const char* Ks, const bf16x8* qr, const f32x16& negm, f32x16& Y0, f32x16& Y1, float alY, float& l_reg,
                                                          bf16x8& pa0, bf16x8& pa1, bf16x8& pa2, bf16x8& pa3, int r32, int hi) {
  constexpr int KROW = KCfg<NKS>::KROW;
  const char* kp = Ks + r32 * KROW + hi * 16;
  bf16x8 ka0 = *reinterpret_cast<const bf16x8*>(kp), ka1 = *reinterpret_cast<const bf16x8*>(kp + 32 * KROW), kb0 = *reinterpret_cast<const bf16x8*>(kp + 32), kb1 = *reinterpret_cast<const bf16x8*>(kp + 32 * KROW + 32);
  float sacc = 0.f; unsigned cv[16]; u32x4 w[4]; SBAR();
  r1_steps<NKS, 0>(X0, X1, kp, qr, negm, Y0, Y1, sacc, cv, w, ka0, ka1, kb0, kb1);
  { auto rr = __builtin_amdgcn_permlane32_swap(__float_as_uint(sacc), __float_as_uint(sacc), false, false); sacc = __uint_as_float(rr[0]) + __uint_as_float(rr[1]); }
  l_reg = l_reg * alY + sacc;
  pa0 = *reinterpret_cast<bf16x8*>(&w[0]); pa1 = *reinterpret_cast<bf16x8*>(&w[1]); pa2 = *reinterpret_cast<bf16x8*>(&w[2]); pa3 = *reinterpret_cast<bf16x8*>(&w[3]);
}
#define PVM(OD, PA, L, H) OD = __builtin_amdgcn_mfma_f32_32x32x16_bf16(PA, ((bf16x8){L[0], L[1], L[2], L[3], H[0], H[1], H[2], H[3]}), OD, 0, 0, 0)
template <bool BND = false> __device__ __forceinline__ void region2(f32x16* o, int vb, bf16x8 pa0, bf16x8 pa1, bf16x8 pa2, bf16x8 pa3, f32x16& X0, f32x16& X1, float& m_ref, f32x16& negm, float& alpha, const float THRL) {
  if constexpr (BND) {
    VFrag fb; alpha = 1.f;
#define EX1(i) X0[i] = __builtin_amdgcn_exp2f(X0[i]); X1[i] = __builtin_amdgcn_exp2f(X1[i]); asm volatile("" : "+v"(X0), "+v"(X1))
    SBAR(); v_read8<0>(fb, vb); SBAR();
    PVM(o[0], pa0, fb.l0, fb.h0); EX1(0); SBAR();
    PVM(o[0], pa1, fb.l1, fb.h1); EX1(1); SBAR();
    PVM(o[0], pa2, fb.l2, fb.h2); EX1(2); SBAR();
    PVM(o[0], pa3, fb.l3, fb.h3); EX1(3); SBAR();
    v_read8<1>(fb, vb); SBAR();
    PVM(o[1], pa0, fb.l0, fb.h0); EX1(4); SBAR();
    PVM(o[1], pa1, fb.l1, fb.h1); EX1(5); SBAR();
    PVM(o[1], pa2, fb.l2, fb.h2); EX1(6); SBAR();
    PVM(o[1], pa3, fb.l3, fb.h3); EX1(7); SBAR();
    v_read8<2>(fb, vb); SBAR();
    PVM(o[2], pa0, fb.l0, fb.h0); EX1(8); SBAR();
    PVM(o[2], pa1, fb.l1, fb.h1); EX1(9); SBAR();
    PVM(o[2], pa2, fb.l2, fb.h2); EX1(10); SBAR();
    PVM(o[2], pa3, fb.l3, fb.h3); EX1(11); SBAR();
    v_read8<3>(fb, vb); SBAR();
    PVM(o[3], pa0, fb.l0, fb.h0); EX1(12); SBAR();
    PVM(o[3], pa1, fb.l1, fb.h1); EX1(13); SBAR();
    PVM(o[3], pa2, fb.l2, fb.h2); EX1(14); SBAR();
    PVM(o[3], pa3, fb.l3, fb.h3); EX1(15); SBAR();
#undef EX1
    return; }
  VFrag fa; float a, b;
  SBAR(); v_read8<0>(fa, vb); SBAR();
  PVM(o[0], pa0, fa.l0, fa.h0); a = MX3(X0[0], X0[1], X1[0]); b = MX3(X0[2], X0[3], X1[1]); SBAR();
  PVM(o[0], pa1, fa.l1, fa.h1); a = MX3(a, X1[2], X1[3]); a = MX3(a, X0[4], X0[5]); SBAR();
  PVM(o[0], pa2, fa.l2, fa.h2); b = MX3(b, X0[6], X0[7]); a = MX3(a, X1[4], X1[5]); SBAR();
  PVM(o[0], pa3, fa.l3, fa.h3); b = MX3(b, X1[6], X1[7]); a = MX3(a, X0[8], X0[9]); SBAR();
  v_read8<1>(fa, vb); SBAR();
  PVM(o[1], pa0, fa.l0, fa.h0); b = MX3(b, X0[10], X0[11]); a = MX3(a, X1[8], X1[9]); SBAR();
  PVM(o[1], pa1, fa.l1, fa.h1); b = MX3(b, X1[10], X1[11]); a = MX3(a, X0[12], X0[13]); SBAR();
  PVM(o[1], pa2, fa.l2, fa.h2); b = MX3(b, X0[14], X0[15]); a = MX3(a, X1[12], X1[13]); SBAR();
  PVM(o[1], pa3, fa.l3, fa.h3); b = MX3(b, X1[14], X1[15]); float rm = __builtin_fmaxf(a, b);
  { auto rr = __builtin_amdgcn_permlane32_swap(__float_as_uint(rm), __float_as_uint(rm), false, false); rm = __builtin_fmaxf(__uint_as_float(rr[0]), __uint_as_float(rr[1])); }
  SBAR(); v_read8<2>(fa, vb); SBAR();
  alpha = 1.f;
  if (__builtin_expect(__any(rm > THRL), 0)) {
    const float dl = fmaxf(rm, 0.f);
#pragma unroll
    for (int r = 0; r < 16; ++r) { X0[r] -= dl; X1[r] -= dl; }
#pragma unroll
    for (int r = 0; r < 16; ++r) negm[r] -= dl;
    alpha = __builtin_amdgcn_exp2f(-dl);
  }
  SBAR();
#define EX2(i) X0[i] = __builtin_amdgcn_exp2f(X0[i]); X0[i + 1] = __builtin_amdgcn_exp2f(X0[i + 1]); X1[i] = __builtin_amdgcn_exp2f(X1[i]); X1[i + 1] = __builtin_amdgcn_exp2f(X1[i + 1]); asm volatile("" : "+v"(X0), "+v"(X1))
  PVM(o[2], pa0, fa.l0, fa.h0); EX2(0); SBAR();
  PVM(o[2], pa1, fa.l1, fa.h1); EX2(2); SBAR();
  PVM(o[2], pa2, fa.l2, fa.h2); EX2(4); SBAR();
  PVM(o[2], pa3, fa.l3, fa.h3); EX2(6); SBAR();
  v_read8<3>(fa, vb); SBAR();
  PVM(o[3], pa0, fa.l0, fa.h0); EX2(8); SBAR();
  PVM(o[3], pa1, fa.l1, fa.h1); EX2(10); SBAR();
  PVM(o[3], pa2, fa.l2, fa.h2); EX2(12); SBAR();
  PVM(o[3], pa3, fa.l3, fa.h3); EX2(14); SBAR();
#undef EX2
}
#undef PVM

template <int NKS, int SD, int QL, bool DBL, int NSLOT, int ldq, int ldk, int ldv, bool BND = false>
__device__ __forceinline__ void attn_pass(const bf16_t* __restrict__ Qb, const bf16_t* __restrict__ Kh, const bf16_t* __restrict__ Vh,
                                          const int seq, char* lds, const float THRL, f32x16 (&o)[4], const int wave_) {
  using KC = KCfg<NKS>; constexpr int KROW = KC::KROW, SHM_K = KC::SHM_K, CPR = KC::CPR, NCH = KC::NCH;
  int wv_ = wave_; asm volatile("" : "+s"(wv_));
  const int lane = fresh_lane(), wid = wv_, tid = wid * 64 + lane, r32 = lane & 31, hi = lane >> 5;
  char* V_lds = lds; char* K_lds = lds + NSLOT * SHM_V;
  float* ws = (float*)(lds + NSLOT * SHM_V + NSLOT * SHM_K) + wid * 64; float* li_l = ws; float* al_l = ws + 32;
  float m_reg = 0.f, l_reg = 0; bf16x8 qr[NKS - QL]; f32x16 negm = f32x16{}; if constexpr (!BND) asm volatile("" : "+v"(negm));
  constexpr int QROW = QL * 32 + 16; char* ql = lds + NSLOT * SHM_V + NSLOT * SHM_K + NW * 64 * 4 + wid * (32 * QROW) + r32 * QROW + hi * 16;
#pragma unroll
  for (int d = 0; d < 4; ++d) o[d] = f32x16{};
  const bf16_t* Qw = Qb + (long)(wid * QBLK + r32) * ldq + hi * 8;
#pragma unroll
  for (int d0 = 0; d0 < NKS; ++d0) { const bf16x8 qv = *reinterpret_cast<const bf16x8*>(Qw + d0 * 16); if (d0 < NKS - QL) qr[d0 < NKS - QL ? d0 : 0] = qv; else *reinterpret_cast<bf16x8*>(ql + (d0 - (NKS - QL)) * 32) = qv; }
  const int sr = tid >> 4, sc = (tid & 15) * 8, vst0 = v_st(sr, sc), vst1 = v_st(32 + sr, sc);
  const unsigned vgo0 = (unsigned)(sr * ldv + sc) * 2u, vgo1 = (unsigned)((32 + sr) * ldv + sc) * 2u;
  unsigned kgo[NCH]; int klo[NCH];
#pragma unroll
  for (int i = 0; i < NCH; ++i) { const int id = tid + 512 * i, row = id / CPR, ch = id % CPR; kgo[i] = (unsigned)(row * ldk + ch * 8) * 2u; klo[i] = row * KROW + ch * 16; }
  const __amdgpu_buffer_rsrc_t srdK = make_srd(Kh, (unsigned)seq * (unsigned)(ldk * 2)), srdV = make_srd(Vh, (unsigned)seq * (unsigned)(ldv * 2));
  const int vb0 = (int)(uintptr_t)V_lds + v_rd_base(lane);
  struct { bf16x8 vs0, vs1, ks[NCH]; } sr_[SD];
#define SLOAD(i, k0) do { const unsigned vso_ = (unsigned)(k0) * (unsigned)(ldv * 2), kso_ = (unsigned)(k0) * (unsigned)(ldk * 2); \
    sr_[i].vs0 = buf_ld16(srdV, vgo0, vso_); sr_[i].vs1 = buf_ld16(srdV, vgo1, vso_); \
    _Pragma("unroll") for (int c_ = 0; c_ < NCH; ++c_) sr_[i].ks[c_] = buf_ld16(srdK, kgo[c_], kso_); } while (0)
#define SWRITE(b, i) do { *(bf16x8*)(V_lds + (b) * SHM_V + vst0) = sr_[i].vs0; *(bf16x8*)(V_lds + (b) * SHM_V + vst1) = sr_[i].vs1; \
    _Pragma("unroll") for (int c_ = 0; c_ < NCH; ++c_) *(bf16x8*)(K_lds + (b) * SHM_K + klo[c_]) = sr_[i].ks[c_]; } while (0)
#define SWAIT() do { if constexpr (SD == 2) { if constexpr (NCH == 1) asm volatile("s_waitcnt vmcnt(3)" ::: "memory"); else if constexpr (NCH == 2) asm volatile("s_waitcnt vmcnt(4)" ::: "memory"); else asm volatile("s_waitcnt vmcnt(5)" ::: "memory"); } \
    else asm volatile("s_waitcnt vmcnt(0)" ::: "memory"); } while (0)
#define RESC(a) do { if constexpr (!BND) if (__any((a) < 1.f)) { if (hi == 0) al_l[r32] = (a); asm volatile("s_waitcnt lgkmcnt(0)" ::: "memory"); \
    _Pragma("unroll") for (int d = 0; d < 4; ++d) _Pragma("unroll") for (int r = 0; r < 16; ++r) o[d][r] *= al_l[crow(r, hi)]; } } while (0)
  const int NT = seq / KVBLK; constexpr int SE = 0, SO = SD - 1;
  if constexpr (!DBL) {
    static_assert(SD == 1, "single-state loop stages one tile ahead");
    f32x16 p0, p1; float mn, al; bf16x8 pa0, pa1, pa2, pa3;
    SLOAD(0, 0); asm volatile("s_waitcnt vmcnt(0)" ::: "memory"); SWRITE(0, 0); __syncthreads();
    for (int j = 0; j < NT; j += 2) {
      SLOAD(0, (j + 1) * KVBLK); SBAR();
      qkt<NKS, QL>(p0, p1, K_lds, qr, ql, negm, r32, hi); partialSM<BND>(p0, p1, m_reg, negm, al, THRL); RESC(al);
      finishSM(p0, p1, al, l_reg, pa0, pa1, pa2, pa3); SBAR();
      pv_d0(o, vb0, pa0, pa1, pa2, pa3);
      SWAIT(); SWRITE(1, 0); __syncthreads();
      if (j + 2 < NT) SLOAD(0, (j + 2) * KVBLK); SBAR();
      qkt<NKS, QL>(p0, p1, K_lds + SHM_K, qr, ql, negm, r32, hi); partialSM<BND>(p0, p1, m_reg, negm, al, THRL); RESC(al);
      finishSM(p0, p1, al, l_reg, pa0, pa1, pa2, pa3); SBAR();
      pv_d0(o, vb0 + SHM_V, pa0, pa1, pa2, pa3);
      if (j + 2 < NT) { SWAIT(); SWRITE(0, 0); } __syncthreads();
    }
  } else if constexpr (NSLOT == 3) {
    static_assert(SD == 1, "ring loop stages one tile ahead");
    f32x16 pA0, pA1, pB0, pB1; float alA, alB; bf16x8 pa0, pa1, pa2, pa3;
    SLOAD(0, 0); asm volatile("s_waitcnt vmcnt(0)" ::: "memory"); SWRITE(0, 0); __syncthreads();
    SLOAD(0, KVBLK);
    constexpr bool HS = HANDSCHED && QL == 0 && (NKS == 4 || NKS == 8);
    qkt<NKS, QL>(pA0, pA1, K_lds, qr, ql, negm, r32, hi); partialSM<BND>(pA0, pA1, m_reg, negm, alA, THRL);
    if constexpr (HS) {
#pragma unroll
      for (int r = 0; r < 16; ++r) pA1[r] = __builtin_amdgcn_exp2f(pA1[r]); }
    SWAIT(); SWRITE(1, 0); __syncthreads();
    int sp = 0, scur = 1, sn = 2;
#define RSTEP(PX0, PX1, ALX, PY0, PY1, ALY, TJ) do { \
      SLOAD(0, ((TJ) + 1) * KVBLK); SBAR(); \
      if constexpr (HS) { \
        region1<NKS>(PX0, PX1, K_lds + scur * SHM_K, qr, negm, PY0, PY1, ALY, l_reg, pa0, pa1, pa2, pa3, r32, hi); \
        region2<BND>(o, vb0 + sp * SHM_V, pa0, pa1, pa2, pa3, PX0, PX1, m_reg, negm, ALX, THRL); \
      } else { \
      qkt<NKS, QL>(PX0, PX1, K_lds + scur * SHM_K, qr, ql, negm, r32, hi); \
      finishSM(PY0, PY1, ALY, l_reg, pa0, pa1, pa2, pa3); SBAR(); \
      pv_d0(o, vb0 + sp * SHM_V, pa0, pa1, pa2, pa3); partialSM<BND>(PX0, PX1, m_reg, negm, ALX, THRL); } \
      SWAIT(); SWRITE(sn, 0); RESC(ALX); __syncthreads(); \
      { const int t_ = sp; sp = scur; scur = sn; sn = t_; } } while (0)
    for (int j = 1; j + 1 < NT; j += 2) {
      RSTEP(pB0, pB1, alB, pA0, pA1, alA, j);
      RSTEP(pA0, pA1, alA, pB0, pB1, alB, j + 1);
    }
#undef RSTEP
    SBAR(); qkt<NKS, QL>(pB0, pB1, K_lds + scur * SHM_K, qr, ql, negm, r32, hi);
    finishSM<!HS>(pA0, pA1, alA, l_reg, pa0, pa1, pa2, pa3); SBAR();
    pv_d0(o, vb0 + sp * SHM_V, pa0, pa1, pa2, pa3); partialSM<BND>(pB0, pB1, m_reg, negm, alB, THRL);
    RESC(alB);
    finishSM(pB0, pB1, alB, l_reg, pa0, pa1, pa2, pa3); SBAR();
    pv_d0(o, vb0 + scur * SHM_V, pa0, pa1, pa2, pa3);
  } else {
  f32x16 pA0, pA1, pB0, pB1; float mnA, mnB, alA, alB; bf16x8 pa0, pa1, pa2, pa3;
  SLOAD(SE, 0); asm volatile("s_waitcnt vmcnt(0)" ::: "memory"); SWRITE(0, SE); __syncthreads();
  qkt<NKS, QL>(pA0, pA1, K_lds, qr, ql, negm, r32, hi); partialSM(pA0, pA1, m_reg, negm, alA, THRL);
  SLOAD(SO, KVBLK); if constexpr (SD == 2) { if (2 < NT) SLOAD(SE, 2 * KVBLK); }
  SWAIT(); SWRITE(1, SO); __syncthreads();
  for (int j = 1; j + 1 < NT; j += 2) {
    SBAR(); qkt<NKS, QL>(pB0, pB1, K_lds + SHM_K, qr, ql, negm, r32, hi);
    finishSM(pA0, pA1, alA, l_reg, pa0, pa1, pa2, pa3); SBAR();
    SLOAD(SO, (j + SD) * KVBLK); SBAR();
    pv_d0(o, vb0, pa0, pa1, pa2, pa3); partialSM(pB0, pB1, m_reg, negm, alB, THRL);
    __syncthreads(); SWAIT(); SWRITE(0, SE);
    RESC(alB); __syncthreads();
    SBAR(); qkt<NKS, QL>(pA0, pA1, K_lds, qr, ql, negm, r32, hi);
    finishSM(pB0, pB1, alB, l_reg, pa0, pa1, pa2, pa3); SBAR();
    if (SD == 1 || j + 3 < NT) SLOAD(SE, (j + 1 + SD) * KVBLK); SBAR();
    pv_d0(o, vb0 + SHM_V, pa0, pa1, pa2, pa3); partialSM(pA0, pA1, m_reg, negm, alA, THRL);
    __syncthreads(); SWAIT(); SWRITE(1, SO);
    RESC(alA); __syncthreads();
  }
  SBAR(); qkt<NKS, QL>(pB0, pB1, K_lds + SHM_K, qr, ql, negm, r32, hi);
  finishSM(pA0, pA1, alA, l_reg, pa0, pa1, pa2, pa3); SBAR();
  pv_d0(o, vb0, pa0, pa1, pa2, pa3); partialSM(pB0, pB1, m_reg, negm, alB, THRL);
  __syncthreads(); RESC(alB);
  finishSM(pB0, pB1, alB, l_reg, pa0, pa1, pa2, pa3); SBAR();
  pv_d0(o, vb0 + SHM_V, pa0, pa1, pa2, pa3);
  }
  if (hi == 0) li_l[r32] = l_reg; asm volatile("s_waitcnt lgkmcnt(0)" ::: "memory");
#pragma unroll
  for (int r = 0; r < 16; ++r) { const float rl = __builtin_amdgcn_rcpf(li_l[crow(r, hi)]);
#pragma unroll
    for (int d = 0; d < 4; ++d) o[d][r] *= rl; }
  __syncthreads();
#undef SLOAD
#undef SWRITE
#undef SWAIT
#undef RESC
}
namespace a16 {
#ifndef ATT16_HS
#define ATT16_HS 1
#endif
constexpr bool A16_HS = ATT16_HS != 0;
constexpr int VROW = 288, SHM_V16 = KVBLK * VROW;
template <int NS> struct Cfg { static constexpr int DQK = NS * 32, KROW = NS == 2 ? 160 : NS == 4 ? 288 : 416, SHM_K = KVBLK * KROW, CPR = DQK / 8, NCH = DQK / 64; static_assert(NS == 2 || NS == 4 || NS == 6, "QK dim 64, 128 or 192"); };
template <int NS> constexpr int NSLOT16 = NS == 6 ? 2 : 3;
template <int NS> constexpr int lds_bytes() { return NSLOT16<NS> * (SHM_V16 + Cfg<NS>::SHM_K) + NW * 64 * 4; }
typedef float f32x4 __attribute__((ext_vector_type(4)));
template <int OFF> __device__ __forceinline__ s16x4 trd(int vb) { return __builtin_bit_cast(s16x4, __builtin_amdgcn_ds_read_tr16_b64_v4i16((__attribute__((address_space(3))) v4i16_t*)(uintptr_t)(unsigned)(vb + OFF))); }
struct PState { f32x4 p[2][4]; };
template <int NS> __device__ __forceinline__ void qkt16(PState& X, const char* kbase, const bf16x8 (&qf)[2][NS]) {
  constexpr int KROW = Cfg<NS>::KROW;
#pragma unroll
  for (int kb = 0; kb < 4; ++kb)
#pragma unroll
    for (int s = 0; s < NS; ++s) { const bf16x8 kf = *reinterpret_cast<const bf16x8*>(kbase + kb * 16 * KROW + s * 64);
#pragma unroll
      for (int qg = 0; qg < 2; ++qg) X.p[qg][kb] = __builtin_amdgcn_mfma_f32_16x16x32_bf16(kf, qf[qg][s], s == 0 ? (f32x4){0.f, 0.f, 0.f, 0.f} : X.p[qg][kb], 0, 0, 0); }
}
__device__ __forceinline__ void exp16(PState& X) {
#pragma unroll
  for (int qg = 0; qg < 2; ++qg)
#pragma unroll
    for (int kb = 0; kb < 4; ++kb)
#pragma unroll
      for (int r = 0; r < 4; ++r) X.p[qg][kb][r] = __builtin_amdgcn_exp2f(X.p[qg][kb][r]);
}
__device__ __forceinline__ void finish16(const PState& Y, float (&l)[8], bf16x8 (&pa)[2][2]) {
#pragma unroll
  for (int qg = 0; qg < 2; ++qg) { float s = 0.f;
#pragma unroll
    for (int kb = 0; kb < 4; ++kb) s += (Y.p[qg][kb][0] + Y.p[qg][kb][1]) + (Y.p[qg][kb][2] + Y.p[qg][kb][3]);
    l[4 * qg] += s;
#pragma unroll
    for (int sp = 0; sp < 2; ++sp) { u32x4 w; w.x = cvtpk(Y.p[qg][2 * sp][0], Y.p[qg][2 * sp][1]); w.y = cvtpk(Y.p[qg][2 * sp][2], Y.p[qg][2 * sp][3]);
      w.z = cvtpk(Y.p[qg][2 * sp + 1][0], Y.p[qg][2 * sp + 1][1]); w.w = cvtpk(Y.p[qg][2 * sp + 1][2], Y.p[qg][2 * sp + 1][3]); pa[qg][sp] = *reinterpret_cast<bf16x8*>(&w); } }
}
template <int CB> __device__ __forceinline__ void pv_cb(f32x4 (&o)[2][8], int vb, const bf16x8 (&pa)[2][2]) {
  const s16x4 l0 = trd<0 * VROW + CB * 32>(vb), h0 = trd<16 * VROW + CB * 32>(vb), l1 = trd<32 * VROW + CB * 32>(vb), h1 = trd<48 * VROW + CB * 32>(vb);
  const bf16x8 v0 = (bf16x8){l0[0], l0[1], l0[2], l0[3], h0[0], h0[1], h0[2], h0[3]}, v1 = (bf16x8){l1[0], l1[1], l1[2], l1[3], h1[0], h1[1], h1[2], h1[3]};
  o[0][CB] = __builtin_amdgcn_mfma_f32_16x16x32_bf16(pa[0][0], v0, o[0][CB], 0, 0, 0); o[1][CB] = __builtin_amdgcn_mfma_f32_16x16x32_bf16(pa[1][0], v0, o[1][CB], 0, 0, 0);
  o[0][CB] = __builtin_amdgcn_mfma_f32_16x16x32_bf16(pa[0][1], v1, o[0][CB], 0, 0, 0); o[1][CB] = __builtin_amdgcn_mfma_f32_16x16x32_bf16(pa[1][1], v1, o[1][CB], 0, 0, 0);
}
__device__ __forceinline__ void pv16(f32x4 (&o)[2][8], int vb, const bf16x8 (&pa)[2][2]) {
  pv_cb<0>(o, vb, pa); pv_cb<1>(o, vb, pa); pv_cb<2>(o, vb, pa); pv_cb<3>(o, vb, pa); pv_cb<4>(o, vb, pa); pv_cb<5>(o, vb, pa); pv_cb<6>(o, vb, pa); pv_cb<7>(o, vb, pa);
}
template <int S> __device__ __forceinline__ void fin16_slot(const PState& Y, float (&l)[8], unsigned (&cw)[2][2][4]) {
  constexpr int qg = S / 24, u = S % 24;
  if constexpr (u < 16) { float x_ = Y.p[qg][u >> 2][u & 3]; asm("v_add_f32_e32 %0, %1, %0" : "+v"(l[4 * qg + (u & 3)]) : "v"(x_)); }
  else { constexpr int w = u - 16, sp = w >> 2, i = w & 3, kb = 2 * sp + (i >> 1), r0 = (i & 1) * 2; cw[qg][sp][i] = cvtpk(Y.p[qg][kb][r0], Y.p[qg][kb][r0 + 1]); }
}
template <int S0, int S1> __device__ __forceinline__ void fin16_slots(const PState& Y, float (&l)[8], unsigned (&cw)[2][2][4]) {
  if constexpr (S0 < S1) { fin16_slot<S0>(Y, l, cw); fin16_slots<S0 + 1, S1>(Y, l, cw); }
}
template <int NS, int T> __device__ __forceinline__ void r1_16(PState& X, const char* kbase, const bf16x8 (&qf)[2][NS], const PState& Y, float (&l)[8], unsigned (&cw)[2][2][4], bf16x8& k0, bf16x8& k1, bf16x8& k2) {
  if constexpr (T < 4 * NS) { constexpr int KROW = Cfg<NS>::KROW, NM = 8 * NS, kb = T / NS, s = T % NS;
    bf16x8& kc = (T % 3 == 0) ? k0 : (T % 3 == 1) ? k1 : k2;
    if constexpr (T + 2 < 4 * NS) { bf16x8& kn = ((T + 2) % 3 == 0) ? k0 : ((T + 2) % 3 == 1) ? k1 : k2; kn = *reinterpret_cast<const bf16x8*>(kbase + ((T + 2) / NS) * 16 * KROW + ((T + 2) % NS) * 64); }
    X.p[0][kb] = __builtin_amdgcn_mfma_f32_16x16x32_bf16(kc, qf[0][s], s == 0 ? (f32x4){0.f, 0.f, 0.f, 0.f} : X.p[0][kb], 0, 0, 0);
    fin16_slots<(48 * (2 * T)) / NM, (48 * (2 * T + 1)) / NM>(Y, l, cw); SBAR();
    X.p[1][kb] = __builtin_amdgcn_mfma_f32_16x16x32_bf16(kc, qf[1][s], s == 0 ? (f32x4){0.f, 0.f, 0.f, 0.f} : X.p[1][kb], 0, 0, 0);
    fin16_slots<(48 * (2 * T + 1)) / NM, (48 * (2 * T + 2)) / NM>(Y, l, cw); SBAR();
    r1_16<NS, T + 1>(X, kbase, qf, Y, l, cw, k0, k1, k2); }
}
template <int NS> __device__ __forceinline__ void region1_16(PState& X, const char* kbase, const bf16x8 (&qf)[2][NS], const PState& Y, float (&l)[8], bf16x8 (&pa)[2][2]) {
  constexpr int KROW = Cfg<NS>::KROW;
  bf16x8 k0 = *reinterpret_cast<const bf16x8*>(kbase), k1 = *reinterpret_cast<const bf16x8*>(kbase + (1 / NS) * 16 * KROW + (1 % NS) * 64), k2;
  unsigned cw[2][2][4]; SBAR();
  r1_16<NS, 0>(X, kbase, qf, Y, l, cw, k0, k1, k2);
#pragma unroll
  for (int qg = 0; qg < 2; ++qg)
#pragma unroll
    for (int sp = 0; sp < 2; ++sp) { u32x4 w = {cw[qg][sp][0], cw[qg][sp][1], cw[qg][sp][2], cw[qg][sp][3]}; pa[qg][sp] = *reinterpret_cast<bf16x8*>(&w); }
}
__device__ __forceinline__ void region2_16(f32x4 (&o)[2][8], int vb, const bf16x8 (&pa)[2][2], PState& X) {
  s16x4 a0, a1, a2, a3, b0, b1, b2, b3, c0, c1, c2, c3;
#define VRD(P, CB) P##0 = trd<0 * VROW + (CB) * 32>(vb); P##1 = trd<16 * VROW + (CB) * 32>(vb); P##2 = trd<32 * VROW + (CB) * 32>(vb); P##3 = trd<48 * VROW + (CB) * 32>(vb)
#define PK8(L, H) ((bf16x8){L[0], L[1], L[2], L[3], H[0], H[1], H[2], H[3]})
#define EXQ(CB, r) X.p[(CB) >> 2][(CB) & 3][r] = __builtin_amdgcn_exp2f(X.p[(CB) >> 2][(CB) & 3][r]); asm volatile("" : "+v"(X.p[(CB) >> 2][(CB) & 3]))
#define BLK(P, CB) \
  o[0][CB] = __builtin_amdgcn_mfma_f32_16x16x32_bf16(pa[0][0], PK8(P##0, P##1), o[0][CB], 0, 0, 0); EXQ(CB, 0); SBAR(); \
  o[1][CB] = __builtin_amdgcn_mfma_f32_16x16x32_bf16(pa[1][0], PK8(P##0, P##1), o[1][CB], 0, 0, 0); EXQ(CB, 1); SBAR(); \
  o[0][CB] = __builtin_amdgcn_mfma_f32_16x16x32_bf16(pa[0][1], PK8(P##2, P##3), o[0][CB], 0, 0, 0); EXQ(CB, 2); SBAR(); \
  o[1][CB] = __builtin_amdgcn_mfma_f32_16x16x32_bf16(pa[1][1], PK8(P##2, P##3), o[1][CB], 0, 0, 0); EXQ(CB, 3); SBAR()
  SBAR(); VRD(a, 0); SBAR();
  VRD(b, 1); SBAR(); BLK(a, 0);
  VRD(c, 2); SBAR(); BLK(b, 1);
  VRD(a, 3); SBAR(); BLK(c, 2);
  VRD(b, 4); SBAR(); BLK(a, 3);
  VRD(c, 5); SBAR(); BLK(b, 4);
  VRD(a, 6); SBAR(); BLK(c, 5);
  VRD(b, 7); SBAR(); BLK(a, 6);
  BLK(b, 7);
#undef VRD
#undef PK8
#undef EXQ
#undef BLK
}
template <int NS, int ldq, int ldk, int ldv>
__device__ __forceinline__ void attn_pass16(const bf16_t* __restrict__ Qb, const bf16_t* __restrict__ Kh, const bf16_t* __restrict__ Vh, const int seq, char* lds, f32x4 (&o)[2][8], const int wave_) {
  using KC = Cfg<NS>; constexpr int KROW = KC::KROW, SHM_K = KC::SHM_K, CPR = KC::CPR, NCH = KC::NCH;
  int wv_ = wave_; asm volatile("" : "+s"(wv_));
  const int lane = fresh_lane(), wid = wv_, tid = wid * 64 + lane, c = lane & 15, g = lane >> 4;
  constexpr int NSL = NSLOT16<NS>;
  char* V_lds = lds; char* K_lds = lds + NSL * SHM_V16;
  float* li_l = (float*)(lds + NSL * SHM_V16 + NSL * SHM_K) + wid * 64;
  float l[8] = {0.f, 0.f, 0.f, 0.f, 0.f, 0.f, 0.f, 0.f};
#pragma unroll
  for (int qg = 0; qg < 2; ++qg)
#pragma unroll
    for (int cb = 0; cb < 8; ++cb) o[qg][cb] = (f32x4){0.f, 0.f, 0.f, 0.f};
  bf16x8 qf[2][NS];
#pragma unroll
  for (int qg = 0; qg < 2; ++qg)
#pragma unroll
    for (int s = 0; s < NS; ++s) qf[qg][s] = *reinterpret_cast<const bf16x8*>(Qb + (long)(wid * QBLK + qg * 16 + c) * ldq + s * 32 + g * 8);
  const int sr = tid >> 4, sc = (tid & 15) * 8, vst0 = sr * VROW + sc * 2, vst1 = (32 + sr) * VROW + sc * 2;
  const unsigned vgo0 = (unsigned)(sr * ldv + sc) * 2u, vgo1 = (unsigned)((32 + sr) * ldv + sc) * 2u;
  unsigned kgo[NCH]; int klo[NCH];
#pragma unroll
  for (int i = 0; i < NCH; ++i) { const int id = tid + 512 * i, row = id / CPR, ch = id % CPR; kgo[i] = (unsigned)(row * ldk + ch * 8) * 2u; klo[i] = row * KROW + ch * 16; }
  const int vb0 = (int)(uintptr_t)V_lds + (4 * g + (c >> 2)) * VROW + (c & 3) * 8;
  const int koff = c * KROW + g * 16;
  bf16x8 vs0, vs1, ks[NCH];
  const __amdgpu_buffer_rsrc_t srdK = make_srd(Kh, (unsigned)seq * (unsigned)(ldk * 2)), srdV = make_srd(Vh, (unsigned)seq * (unsigned)(ldv * 2));
#define SLOAD16(k0) do { const unsigned vso_ = (unsigned)(k0) * (unsigned)(ldv * 2), kso_ = (unsigned)(k0) * (unsigned)(ldk * 2); \
    vs0 = buf_ld16(srdV, vgo0, vso_); vs1 = buf_ld16(srdV, vgo1, vso_); \
    _Pragma("unroll") for (int c_ = 0; c_ < NCH; ++c_) ks[c_] = buf_ld16(srdK, kgo[c_], kso_); } while (0)
#define SWRITE16(b) do { *(bf16x8*)(V_lds + (b) * SHM_V16 + vst0) = vs0; *(bf16x8*)(V_lds + (b) * SHM_V16 + vst1) = vs1; \
    _Pragma("unroll") for (int c_ = 0; c_ < NCH; ++c_) *(bf16x8*)(K_lds + (b) * SHM_K + klo[c_]) = ks[c_]; } while (0)
  const int NT = seq / KVBLK;
  if constexpr (NSL == 2) {
    PState A; bf16x8 pa[2][2];
    SLOAD16(0); asm volatile("s_waitcnt vmcnt(0)" ::: "memory"); SWRITE16(0); __syncthreads();
    for (int j = 0; j < NT; j += 2) {
      SLOAD16((j + 1) * KVBLK); SBAR();
      qkt16<NS>(A, K_lds + koff, qf); exp16(A); finish16(A, l, pa); SBAR();
      pv16(o, vb0, pa);
      asm volatile("s_waitcnt vmcnt(0)" ::: "memory"); SWRITE16(1); __syncthreads();
      if (j + 2 < NT) SLOAD16((j + 2) * KVBLK); SBAR();
      qkt16<NS>(A, K_lds + SHM_K + koff, qf); exp16(A); finish16(A, l, pa); SBAR();
      pv16(o, vb0 + SHM_V16, pa);
      if (j + 2 < NT) { asm volatile("s_waitcnt vmcnt(0)" ::: "memory"); SWRITE16(0); } __syncthreads();
    }
  } else {
  PState A, B; bf16x8 pa[2][2];
  SLOAD16(0); asm volatile("s_waitcnt vmcnt(0)" ::: "memory"); SWRITE16(0); __syncthreads();
  SLOAD16(KVBLK);
  qkt16<NS>(A, K_lds + koff, qf); exp16(A);
  asm volatile("s_waitcnt vmcnt(0)" ::: "memory"); SWRITE16(1); __syncthreads();
  int sp = 0, scur = 1, sn = 2;
#define RSTEP16(X, Y, TJ) do { \
    SLOAD16(((TJ) + 1) * KVBLK); SBAR(); \
    if constexpr (A16_HS) { region1_16<NS>(X, K_lds + scur * SHM_K + koff, qf, Y, l, pa); region2_16(o, vb0 + sp * SHM_V16, pa, X); } else { \
    qkt16<NS>(X, K_lds + scur * SHM_K + koff, qf); \
    finish16(Y, l, pa); SBAR(); \
    pv16(o, vb0 + sp * SHM_V16, pa); exp16(X); } \
    asm volatile("s_waitcnt vmcnt(0)" ::: "memory"); SWRITE16(sn); __syncthreads(); \
    { const int t_ = sp; sp = scur; scur = sn; sn = t_; } } while (0)
  for (int j = 1; j + 1 < NT; j += 2) {
    RSTEP16(B, A, j);
    RSTEP16(A, B, j + 1);
  }
#undef RSTEP16
  SBAR(); qkt16<NS>(B, K_lds + scur * SHM_K + koff, qf);
  finish16(A, l, pa); SBAR();
  pv16(o, vb0 + sp * SHM_V16, pa); exp16(B);
  finish16(B, l, pa); SBAR();
  pv16(o, vb0 + scur * SHM_V16, pa);
  }
  { const float t0 = (l[0] + l[1]) + (l[2] + l[3]), t1 = (l[4] + l[5]) + (l[6] + l[7]); l[0] = t0; l[1] = t1; }
#pragma unroll
  for (int qg = 0; qg < 2; ++qg) { l[qg] += __shfl_xor(l[qg], 16); l[qg] += __shfl_xor(l[qg], 32); }
  if (g == 0) { li_l[c] = l[0]; li_l[16 + c] = l[1]; } asm volatile("s_waitcnt lgkmcnt(0)" ::: "memory");
#pragma unroll
  for (int qg = 0; qg < 2; ++qg)
#pragma unroll
    for (int r = 0; r < 4; ++r) { const float rl = __builtin_amdgcn_rcpf(li_l[qg * 16 + 4 * g + r]);
#pragma unroll
      for (int cb = 0; cb < 8; ++cb) o[qg][cb][r] *= rl; }
  __syncthreads();
#undef SLOAD16
#undef SWRITE16
}
}
#undef SBAR
}
#define GAS __attribute__((address_space(1)))
#define LAS __attribute__((address_space(3)))
typedef unsigned short bf16;
typedef unsigned v4u __attribute__((ext_vector_type(4)));
typedef float f32x4 __attribute__((ext_vector_type(4)));
typedef short bf16x8 __attribute__((ext_vector_type(8)));
typedef GAS unsigned gu32;
typedef GAS unsigned long long gu64;
#define RLX_AGENT __ATOMIC_RELAXED, __HIP_MEMORY_SCOPE_AGENT
#define LDS_WAIT() asm volatile("s_waitcnt lgkmcnt(0)" ::: "memory")
#define VM_WAIT() asm volatile("s_waitcnt vmcnt(0)" ::: "memory")
__device__ __forceinline__ unsigned long long rt() { return __builtin_amdgcn_s_memrealtime(); }
__device__ __forceinline__ unsigned f2bf(float f) { unsigned u = __builtin_bit_cast(unsigned, f); return (u + 0x7fffu + ((u >> 16) & 1u)) >> 16; }
__device__ __forceinline__ unsigned pk2(float lo, float hi) { return f2bf(lo) | (f2bf(hi) << 16); }

#define XB_TMO      128
#define XB_XCNT(j)  (256  + 64 * (j))
#define XB_XSUB(j)  (1280 + 64 * (j))
#define XB_XGEN(j)  (2304 + 64 * (j))
#define XB_TOP      3328
#define XB_TOPGEN   3392
#define XCD_BAR_WORDS 3456
#define XB_SPIN_CAP (1u << 18)

__device__ __forceinline__ unsigned xb_ld(unsigned* p)              { return __hip_atomic_load(p, __ATOMIC_RELAXED, __HIP_MEMORY_SCOPE_AGENT); }
__device__ __forceinline__ unsigned xb_add(unsigned* p, unsigned v) { return __hip_atomic_fetch_add(p, v, __ATOMIC_RELAXED, __HIP_MEMORY_SCOPE_AGENT); }
__device__ __forceinline__ unsigned xb_xcc_id() { return (unsigned)__builtin_amdgcn_s_getreg((3 << 11) | 20) & 0xFu; }
#define XB_SPIN(cond, bar) do { unsigned _sp = 0; while (cond) { __builtin_amdgcn_s_sleep(1); \
    if ((++_sp & 255u) == 0u) { if (xb_ld(&(bar)[XB_TMO])) break; if (_sp > XB_SPIN_CAP) { atomicAdd(&(bar)[XB_TMO], 1u); break; } } } } while (0)

struct XcdBarrier {
    unsigned* bar; unsigned x;
    volatile LAS unsigned* st;
};

__device__ __forceinline__ XcdBarrier xcd_barrier_post(unsigned* bar, volatile LAS unsigned* st) {
    XcdBarrier b; b.bar = bar; b.x = xb_xcc_id(); b.st = st;
    if (threadIdx.x == 0) (void)xb_add(&bar[XB_XCNT(b.x)], 1u);
    return b;
}
__device__ __forceinline__ void xcd_barrier_complete(unsigned* bar, unsigned x, unsigned& nloc, unsigned& nx) {
    const unsigned G = gridDim.x * gridDim.y * gridDim.z;
    unsigned sum, cnt, mine, sp = 0u;
    for (;;) {
        sum = 0u; cnt = 0u; mine = 0u;
#pragma unroll
        for (unsigned j = 0; j < 16; ++j) { const unsigned c = xb_ld(&bar[XB_XCNT(j)]); sum += c; cnt += (c > 0u) ? 1u : 0u; mine = (j == x) ? c : mine; }
        if (sum == G) break;
        __builtin_amdgcn_s_sleep(1);
        if ((++sp & 255u) == 0u) { if (xb_ld(&bar[XB_TMO])) break; if (sp > XB_SPIN_CAP) { atomicAdd(&bar[XB_TMO], 1u); break; } }
    }
    nloc = mine > 0u ? mine : 1u; nx = cnt > 0u ? cnt : 1u;
}

__device__ __forceinline__ void xcd_barrier(const XcdBarrier& b) {
    asm volatile("s_waitcnt vmcnt(0)" ::: "memory");
    __syncthreads();
    if (threadIdx.x == 0) {
        unsigned* bar = b.bar;
        __builtin_amdgcn_s_waitcnt(0);
        unsigned nloc = b.st[0], nx = b.st[1];
        if (nloc == 0u) { xcd_barrier_complete(bar, b.x, nloc, nx); b.st[0] = nloc; b.st[1] = nx; }
        const unsigned old = xb_add(&bar[XB_XSUB(b.x)], 1u);
        const unsigned gen = old / nloc;
        if (old + 1u == (gen + 1u) * nloc) {
            __builtin_amdgcn_fence(__ATOMIC_RELEASE, "agent");
            asm volatile("s_waitcnt vmcnt(0)" ::: "memory");
            const unsigned og = xb_add(&bar[XB_TOP], 1u);
            const unsigned tg = og / nx;
            if (og + 1u == (tg + 1u) * nx) xb_add(&bar[XB_TOPGEN], 1u);
            else XB_SPIN(xb_ld(&bar[XB_TOPGEN]) == tg, bar);
            __builtin_amdgcn_fence(__ATOMIC_ACQUIRE, "agent");
            xb_add(&bar[XB_XGEN(b.x)], 1u);
            asm volatile("s_waitcnt vmcnt(0)" ::: "memory");
        } else {
            XB_SPIN(xb_ld(&bar[XB_XGEN(b.x)]) == gen, bar);
            __builtin_amdgcn_fence(__ATOMIC_ACQUIRE, "agent");
            asm volatile("s_waitcnt vmcnt(0)" ::: "memory");
        }
    }
    __syncthreads();
}
constexpr int NWAVES = 8;
constexpr int SEQ = 8192, DM = 4096, NIN = 7232, NINP = 7424, FF = 11008, DEPTH = 2;
constexpr int A_HEADS = 12, A_KV = 4, B_HEADS = 8, C_HEADS = 12;
constexpr float EPS = 1e-6f;
#ifndef MK_PER_PHASE
#define MK_PER_PHASE 0
#endif
constexpr int N_PHASES = 1 + 8 * DEPTH;

constexpr size_t MiB = 1u << 20;
constexpr size_t WS_CTL = 0, CTL_ZERO_BYTES = 1 * MiB;
constexpr size_t WS_SSQ = 256 * 1024;
constexpr size_t WS_TCC = 2 * MiB, WS_TSC = 3 * MiB, WS_TCB = 4 * MiB, WS_TSB = 4 * MiB + 256 * 1024;
constexpr size_t WS_W0 = 8 * MiB;
constexpr size_t W_IN = 0, W_QUP = 58 * MiB, W_KVUP = 64 * MiB, W_OUT = 67 * MiB, W_GU = 99 * MiB, W_DOWN = 271 * MiB, W_LAYER = 357 * MiB;
constexpr size_t WS_ACT = WS_W0 + 2 * W_LAYER;
constexpr size_t WS_XN = WS_ACT, WS_QA = WS_XN + 64 * MiB, WS_KA = WS_QA + 24 * MiB, WS_VA = WS_KA + 8 * MiB, WS_QB = WS_VA + 8 * MiB, WS_KB = WS_QB + 16 * MiB,
                 WS_VB = WS_KB + 16 * MiB, WS_CQL = WS_VB + 16 * MiB, WS_CKVL = WS_CQL + 16 * MiB, WS_CKR = WS_CKVL + 8 * MiB, WS_QC = WS_CKR + 2 * MiB,
                 WS_KC = WS_QC + 36 * MiB, WS_VC = WS_KC + 36 * MiB, WS_Y = WS_VC + 24 * MiB, WS_ACTB = WS_Y + 64 * MiB, WS_STASH = WS_ACTB + 172 * MiB,
                 WS_END = WS_STASH + 32 * MiB;
static_assert((size_t)NINP * DM * 2 == 58 * MiB && (size_t)3072 * 1024 * 2 == 6 * MiB && (size_t)3072 * 512 * 2 == 3 * MiB && (size_t)DM * DM * 2 == 32 * MiB &&
              (size_t)2 * FF * DM * 2 == 172 * MiB && (size_t)DM * FF * 2 == 86 * MiB, "weight copy sizes");
static_assert((size_t)SEQ * FF * 2 == 172 * MiB && (size_t)SEQ * 2304 * 2 == 36 * MiB, "activation sizes");
constexpr int CW_BAR = 4096;

constexpr int RING_OFF = 0, RING_BYTES = 131072;
constexpr int EPI_OFF = RING_BYTES, EPI_BYTES = 16384;
constexpr int MISC_OFF = EPI_OFF + EPI_BYTES;
constexpr int LDS_BYTES = MISC_OFF + 512;
#define ATT_B_PASS att::attn_pass<4, ATT_SD_B, 0, true, ATT_NSLOT, 1024, 1024, 1024>
#define ATT_B_PASS_BND att::attn_pass<4, ATT_SD_B, 0, true, ATT_NSLOT, 1024, 1024, 1024, true>
#ifndef ATT_NSLOT
#define ATT_NSLOT 3
#endif
#ifndef ATT_SD_A
#define ATT_SD_A 1
#endif
#ifndef ATT_SD_B
#define ATT_SD_B 1
#endif
#ifndef CQL_PARK
#define CQL_PARK 4
#endif
static_assert(att::lds_bytes<12, CQL_PARK>() <= RING_BYTES + EPI_BYTES && att::lds_bytes<8, 0, ATT_NSLOT>() <= RING_BYTES && att::a16::lds_bytes<6>() <= RING_BYTES + EPI_BYTES && att::a16::lds_bytes<4>() <= RING_BYTES + EPI_BYTES, "attention LDS");

typedef unsigned v2u __attribute__((ext_vector_type(2)));
__device__ __forceinline__ unsigned cvtpk2(float lo, float hi) { unsigned r; asm volatile("v_cvt_pk_bf16_f32 %0, %1, %2" : "=v"(r) : "v"(lo), "v"(hi)); return r; }

struct Args { const float* in[20]; float* out; unsigned char* ws; int ph_lo, ph_hi; float lam_init[2]; int seq, pad; };

struct Frame {
    LAS unsigned char* lds; volatile LAS unsigned* MISC;
    int wave, vcu, G;
};
__device__ __forceinline__ int fresh_bx() { int b = (int)blockIdx.x; asm volatile("" : "+s"(b)); return b; }
#define FLANE (fresh_lane())
#define FTID (F.wave * 64 + fresh_lane())
__device__ __forceinline__ float wave_sum(float v) {
#pragma unroll
    for (int o = 1; o < 64; o <<= 1) v += __shfl_xor(v, o);
    return v;
}

template <int MAP> __device__ __forceinline__ int dest_row(int c) {
    if constexpr (MAP == 1) {
        if (c < 2048) { const int l = c & 127, hh = l >> 6, n = (l >> 5) & 1, w = (l >> 4) & 1, fq = (l >> 2) & 3, j = l & 3; return (c & ~127) + (hh * 2 + w) * 32 + fq * 8 + n * 4 + j; }
        if (c >= 2560 && c < 4608) { int l = c & 63; if (l < 16) l = ((l >> 2) & 1) * 8 + (l >> 3) * 4 + (l & 3); return (c & ~63) + l; }
        return c;
    } else if constexpr (MAP == 2) {
        const int h = c / 192, l = c - h * 192; if (l < 128) return h * 256 + l;
        const int lp = l - 128, n = lp >> 5, w = (lp >> 4) & 1, fq = (lp >> 2) & 3, j = lp & 3; return h * 256 + 128 + w * 32 + fq * 8 + n * 4 + j;
    } else if constexpr (MAP == 3) { return (c >> 7) * 256 + (c & 127);
    } else if constexpr (MAP == 4) { return (c >> 7) * 256 + 128 + (c & 127);
    } else return c;
}
__device__ __forceinline__ int dest_row_rt(int map, int c) { return map == 1 ? dest_row<1>(c) : map == 2 ? dest_row<2>(c) : map == 3 ? dest_row<3>(c) : map == 4 ? dest_row<4>(c) : c; }
__device__ __forceinline__ void cvt_items(const Frame& F, const float* __restrict__ W, int K, int N, unsigned short* WT, const float* kscale, int map, int it0, int it_end, int stride) {
    LAS float* scr = (LAS float*)(F.lds + RING_OFF + F.wave * 16384);
    int lane = FLANE; asm volatile("" : "+v"(lane));
    const int NGW = stride, nblk = N / 32, nkb = K / 64, sbi = nkb * 32, nitems = it_end;
    const int lr = lane >> 5, lc = lane & 31;
    float v[32];
    int it = it0;
#define CVT_DECODE(IT, KB, NB) const int sb_ = (IT) / sbi, loc_ = (IT) - sb_ * sbi, KB = loc_ >> 5, NB = sb_ * 32 + (loc_ & 31)
    if (it < nitems) { CVT_DECODE(it, kb, nb); if (nb < nblk) { const GAS float* src = (const GAS float*)W + (size_t)(64 * kb + lr) * N + 32 * nb + lc;
#pragma unroll
        for (int i = 0; i < 32; ++i) v[i] = __builtin_nontemporal_load(src + (size_t)(2 * i) * N); } }
    for (; it < nitems; it += NGW) {
        CVT_DECODE(it, kb, nb); const int k0 = 64 * kb, n0 = 32 * nb; const bool valid = nb < nblk;
        if (valid) {
        if (kscale) {
#pragma unroll
            for (int i = 0; i < 32; ++i) v[i] *= ((const GAS float*)kscale)[k0 + 2 * i + lr]; }
#pragma unroll
        for (int i = 0; i < 32; ++i) scr[(2 * i + lr) * 33 + lc] = v[i];
        }
        const int itn = it + NGW;
        if (itn < nitems) { CVT_DECODE(itn, kbn, nbn); if (nbn < nblk) { const GAS float* src = (const GAS float*)W + (size_t)(64 * kbn + lr) * N + 32 * nbn + lc;
#pragma unroll
            for (int i = 0; i < 32; ++i) v[i] = __builtin_nontemporal_load(src + (size_t)(2 * i) * N); } }
        if (!valid) continue;
        LDS_WAIT(); asm volatile("" ::: "memory");
        const int c = lane & 7;
#pragma unroll
        for (int j = 0; j < 4; ++j) { const int n = (lane >> 3) + 8 * j; const LAS float* s = scr + (8 * c) * 33 + n;
            v4u o; o.x = cvtpk2(s[0 * 33], s[1 * 33]); o.y = cvtpk2(s[2 * 33], s[3 * 33]); o.z = cvtpk2(s[4 * 33], s[5 * 33]); o.w = cvtpk2(s[6 * 33], s[7 * 33]);
            __builtin_nontemporal_store(o, (GAS v4u*)(WT + (size_t)dest_row_rt(map, n0 + n) * K + k0 + 8 * c)); }
        LDS_WAIT(); asm volatile("" ::: "memory");
    }
#undef CVT_DECODE
}

__host__ __device__ constexpr int cvt_nitems(int K, int N) { return ((N / 32 + 31) / 32) * (K / 64) * 32; }
template <int MAP> __device__ __forceinline__ void cvt_matrix(const Frame& F, const float* W, int K, int N, unsigned short* WT, const float* kscale) {
    cvt_items(F, W, K, N, WT, kscale, MAP, F.vcu * NWAVES + F.wave, cvt_nitems(K, N), F.G * NWAVES);
}

#ifndef CVT_PROBE
#define CVT_PROBE 0
#endif
__device__ __forceinline__ void cvt_probe_read(const Frame& F, const float* __restrict__ W, int K, int N) {
    int lane = FLANE; asm volatile("" : "+v"(lane));
    const int gw = F.vcu * NWAVES + F.wave, NGW = F.G * NWAVES, nblk = N / 32, nitems = (K / 64) * nblk;
    const int lr = lane >> 5, lc = lane & 31;
    float acc = 0.f;
    for (int it = gw; it < nitems; it += NGW) { const int kb = it / nblk, nb = it - kb * nblk; const float* src = W + (size_t)(64 * kb + lr) * N + 32 * nb + lc;
        float v[32];
#pragma unroll
        for (int i = 0; i < 32; ++i) v[i] = __builtin_nontemporal_load(src + (size_t)(2 * i) * N);
#pragma unroll
        for (int i = 0; i < 32; ++i) acc += v[i]; }
    asm volatile("" :: "v"(acc));
}

constexpr int QB = 64;
constexpr int QI_GATE = cvt_nitems(DM, FF), QI_DOWN = cvt_nitems(FF, DM), QI_IN = cvt_nitems(DM, NIN), QI_QUP = cvt_nitems(1024, 2304), QI_KVUP = cvt_nitems(512, 3072), QI_OUT = cvt_nitems(DM, DM);
constexpr int QG_FFN = 2 * QI_GATE + QI_DOWN, QG_EARLY = QI_IN + QI_QUP + QI_KVUP + QI_OUT;
constexpr int Q_END_A = QG_FFN, Q_END_B = Q_END_A + QG_EARLY, Q_END_C = Q_END_B + QG_FFN;
static_assert(QG_FFN % QB == 0 && QG_EARLY % QB == 0, "queue groups are whole batches");
constexpr int CW_QHEAD = 8192;
static_assert(QI_GATE % QB == 0 && QI_DOWN % QB == 0 && QI_IN % QB == 0 && QI_QUP % QB == 0 && QI_KVUP % QB == 0 && QI_OUT % QB == 0, "a batch never straddles two matrices");
template <class A> __device__ __forceinline__ void cvt_queue_range(const Frame& F, const A& args, unsigned char* ws, int g0, int g1) {
    typedef unsigned short bf;
    if (g1 > Q_END_C) g1 = Q_END_C;
    while (g0 < g1) {
    const float* W; const float* ks; bf* WT; int K, N, map, jb;
    if (g0 < Q_END_A || g0 >= Q_END_B) {
        const int l = g0 < Q_END_A ? 0 : 1, gb = l ? Q_END_B : 0, r = g0 - gb; unsigned char* wl = ws + WS_W0 + (size_t)l * W_LAYER;
        if (r < QI_GATE) { W = args.in[17] + (size_t)l * DM * FF; K = DM; N = FF; WT = (bf*)(wl + W_GU); ks = args.in[16] + l * DM; map = 3; jb = gb; }
        else if (r < 2 * QI_GATE) { W = args.in[18] + (size_t)l * DM * FF; K = DM; N = FF; WT = (bf*)(wl + W_GU); ks = args.in[16] + l * DM; map = 4; jb = gb + QI_GATE; }
        else { W = args.in[19] + (size_t)l * FF * DM; K = FF; N = DM; WT = (bf*)(wl + W_DOWN); ks = nullptr; map = 0; jb = gb + 2 * QI_GATE; }
    } else {
        const int l = 1, gb = Q_END_A, r = g0 - gb; unsigned char* wl = ws + WS_W0 + (size_t)l * W_LAYER;
        if (r < QI_IN) { W = args.in[2] + (size_t)l * DM * NIN; K = DM; N = NIN; WT = (bf*)(wl + W_IN); ks = args.in[1] + l * DM; map = 1; jb = gb; }
        else if (r < QI_IN + QI_QUP) { W = args.in[11] + (size_t)l * 1024 * 2304; K = 1024; N = 2304; WT = (bf*)(wl + W_QUP); ks = args.in[9] + l * 1024; map = 2; jb = gb + QI_IN; }
        else if (r < QI_IN + QI_QUP + QI_KVUP) { W = args.in[12] + (size_t)l * 512 * 3072; K = 512; N = 3072; WT = (bf*)(wl + W_KVUP); ks = args.in[10] + l * 512; map = 0; jb = gb + QI_IN + QI_QUP; }
        else { W = args.in[15] + (size_t)l * DM * DM; K = DM; N = DM; WT = (bf*)(wl + W_OUT); ks = nullptr; map = 0; jb = gb + QI_IN + QI_QUP + QI_KVUP; }
    }
    const int je = jb + cvt_nitems(K, N), ge = g1 < je ? g1 : je;
    cvt_items(F, W, K, N, WT, ks, map, g0 - jb + F.wave, ge - jb, NWAVES);
    g0 = ge; }
}
constexpr int QMB = 8;
template <class A> __device__ __forceinline__ void xcd_barrier_steal(const XcdBarrier& b, const Frame& F, const A& args, unsigned char* ws) {
    asm volatile("s_waitcnt vmcnt(0)" ::: "memory");
    __syncthreads();
    volatile LAS unsigned* st = b.st;
    if (threadIdx.x == 0) {
        unsigned* bar = b.bar;
        __builtin_amdgcn_s_waitcnt(0);
        unsigned nloc = st[0], nx = st[1];
        if (nloc == 0u) { xcd_barrier_complete(bar, b.x, nloc, nx); st[0] = nloc; st[1] = nx; }
        const unsigned old = xb_add(&bar[XB_XSUB(b.x)], 1u);
        const unsigned gen = old / nloc;
        if (old + 1u == (gen + 1u) * nloc) {
            __builtin_amdgcn_fence(__ATOMIC_RELEASE, "agent");
            asm volatile("s_waitcnt vmcnt(0)" ::: "memory");
            const unsigned og = xb_add(&bar[XB_TOP], 1u);
            const unsigned tg = og / nx;
            if (og + 1u == (tg + 1u) * nx) xb_add(&bar[XB_TOPGEN], 1u);
            else XB_SPIN(xb_ld(&bar[XB_TOPGEN]) == tg, bar);
            __builtin_amdgcn_fence(__ATOMIC_ACQUIRE, "agent");
            xb_add(&bar[XB_XGEN(b.x)], 1u);
            asm volatile("s_waitcnt vmcnt(0)" ::: "memory");
            st[2] = 0u;
        } else { st[2] = 1u; st[3] = gen; }
    }
    __syncthreads();
    gu32* qhead = (gu32*)(ws + WS_CTL) + CW_QHEAD;
    for (unsigned it = 0; st[2] != 0u; ++it) {
        if (threadIdx.x == 0) { unsigned g_ = 0x7fffffffu;
            if (__hip_atomic_load(qhead, __ATOMIC_RELAXED, __HIP_MEMORY_SCOPE_AGENT) < (unsigned)Q_END_C) g_ = __hip_atomic_fetch_add(qhead, (unsigned)QMB, __ATOMIC_RELAXED, __HIP_MEMORY_SCOPE_AGENT);
            st[4] = g_; }
        __syncthreads();
        const int g = (int)st[4];
        if (g < Q_END_C) cvt_queue_range(F, args, ws, g, g + QMB); else __builtin_amdgcn_s_sleep(8);
        asm volatile("s_waitcnt vmcnt(0)" ::: "memory");
        __syncthreads();
        if (threadIdx.x == 0) { unsigned* bar = b.bar; bool done = xb_ld(&bar[XB_XGEN(b.x)]) != st[3];
            if (!done && (it & 63u) == 63u) { if (xb_ld(&bar[XB_TMO])) done = true; else if (it > XB_SPIN_CAP) { atomicAdd(&bar[XB_TMO], 1u); done = true; } }
            if (done) { __builtin_amdgcn_fence(__ATOMIC_ACQUIRE, "agent"); asm volatile("s_waitcnt vmcnt(0)" ::: "memory"); st[2] = 0u; } }
        __syncthreads();
    }
}
template <class A> __device__ __forceinline__ void cvt_steal(const Frame& F, const A& args, unsigned char* ws, int quota, int upto) {
    gu32* qhead = (gu32*)(ws + WS_CTL) + CW_QHEAD;
    __syncthreads();
    for (int b = 0; b < quota || upto > 0; ++b) {
        if (FTID == 0) { unsigned g_ = 0x7fffffffu;
            if (b < quota || __hip_atomic_load(qhead, __ATOMIC_RELAXED, __HIP_MEMORY_SCOPE_AGENT) < (unsigned)upto) g_ = __hip_atomic_fetch_add(qhead, (unsigned)QB, __ATOMIC_RELAXED, __HIP_MEMORY_SCOPE_AGENT);
            F.MISC[16 + (b & 1)] = g_; }
        __syncthreads();
        const int g = (int)F.MISC[16 + (b & 1)];
        if (g >= Q_END_C) break;
        cvt_queue_range(F, args, ws, g, g + QB);
    }
    __syncthreads();
}
__device__ __forceinline__ void norm_rows(const Frame& F, const float* src, const float* gain, unsigned short* dst) {
    int lane = FLANE; asm volatile("" : "+v"(lane));
    const int gw = F.vcu * NWAVES + F.wave, NGW = F.G * NWAVES;
    for (int m = gw; m < SEQ; m += NGW) {
        const GAS f32x4* xr = (const GAS f32x4*)(src + (size_t)m * DM) + lane;
        f32x4 v[16]; float s = 0.f;
#pragma unroll
        for (int j = 0; j < 16; ++j) { v[j] = xr[64 * j]; s += (v[j].x * v[j].x + v[j].y * v[j].y) + (v[j].z * v[j].z + v[j].w * v[j].w); }
        const float rstd = rsqrtf(wave_sum(s) * (1.0f / DM) + EPS);
        GAS v2u* o8 = (GAS v2u*)(dst + (size_t)m * DM) + lane;
#pragma unroll
        for (int j = 0; j < 16; ++j) { const f32x4 g = *((const GAS f32x4*)gain + lane + 64 * j); v2u w; w.x = cvtpk2(v[j].x * rstd * g.x, v[j].y * rstd * g.y); w.y = cvtpk2(v[j].z * rstd * g.z, v[j].w * rstd * g.w); o8[64 * j] = w; }
    }
}
__device__ __forceinline__ void cast_rows(const Frame& F, const float* src, unsigned short* dst, float* ssq) {
    int lane = FLANE; asm volatile("" : "+v"(lane));
    const int gw = F.vcu * NWAVES + F.wave, NGW = F.G * NWAVES;
    for (int m = gw; m < SEQ; m += NGW) {
        const GAS f32x4* xr = (const GAS f32x4*)(src + (size_t)m * DM) + lane;
        f32x4 v[16]; float s = 0.f;
#pragma unroll
        for (int j = 0; j < 16; ++j) { v[j] = xr[64 * j]; s += (v[j].x * v[j].x + v[j].y * v[j].y) + (v[j].z * v[j].z + v[j].w * v[j].w); }
        s = wave_sum(s); if (lane == 0) ssq[m] = s;
        GAS v2u* o8 = (GAS v2u*)(dst + (size_t)m * DM) + lane;
#pragma unroll
        for (int j = 0; j < 16; ++j) { v2u w; w.x = cvtpk2(v[j].x, v[j].y); w.y = cvtpk2(v[j].z, v[j].w); o8[64 * j] = w; }
    }
}
__device__ __forceinline__ void sincos_d(float ang, float& sn, float& cs) {
    const double a = (double)ang; const double kq = __builtin_rint(a * 0.63661977236758134308);
    double r = __builtin_fma(-kq, 1.57079632679489655800e+00, a); r = __builtin_fma(-kq, 6.12323399573676603587e-17, r);
    const int q = (int)kq & 3; const double r2 = r * r;
    const double sp = r + r * r2 * (-1.66666666666666666667e-01 + r2 * (8.33333333333333333333e-03 + r2 * (-1.98412698412698412698e-04 + r2 * (2.75573192239858906526e-06 + r2 * (-2.50521083854417187751e-08 + r2 * 1.60590438368216145994e-10)))));
    const double cp = 1.0 + r2 * (-0.5 + r2 * (4.16666666666666666667e-02 + r2 * (-1.38888888888888888889e-03 + r2 * (2.48015873015873015873e-05 + r2 * (-2.75573192239858906526e-07 + r2 * (2.08767569878680989792e-09 + r2 * -1.14707455977297247139e-11))))));
    const double s = (q & 1) ? cp : sp, c = (q & 1) ? sp : cp;
    sn = (float)((q & 2) ? -s : s); cs = (float)(((q + 1) & 2) ? -c : c);
}
__device__ __forceinline__ void rope_tables(const Frame& F, float* tcC, float* tsC, float* tcB, float* tsB) {
    const int gt = F.vcu * (NWAVES * 64) + FTID, NT = F.G * NWAVES * 64;
    for (int e = gt; e < SEQ * 40; e += NT) {
        const bool isC = e < SEQ * 32; const int ee = isC ? e : e - SEQ * 32; const int pos = isC ? (ee >> 5) : (ee >> 3), i = isC ? (ee & 31) : (ee & 7);
        const double rr = isC ? 0.7498942093324559   : 0.19392274474868576  ;
        double p = 1.0; for (int k = 0; k < i; ++k) p *= rr;
        const float inv = (float)p, ang = (float)pos * inv; float sn, cs; sincos_d(ang, sn, cs);
        if (isC) { tcC[ee] = cs; tsC[ee] = sn; } else { tcB[ee] = cs; tsB[ee] = sn; }
    }
}

__device__ __forceinline__ int attn_unit_id(int G, int bx, int i) {
    if (G == 256) { const int x = bx & 7, r = bx >> 3, y = x >> 1;
        if ((x & 1) == 0) { if (i == 0) return x * 32 + r; if (i == 1) return 256 + y * 96 + r; if (i == 2) return 256 + y * 96 + 32 + r; if (i == 3) return 640 + (3 * y) * 32 + r; }
        else { if (i == 0) return 256 + y * 96 + 64 + r; if (i == 1) return 640 + (3 * y + 1) * 32 + r; if (i == 2) return 640 + (3 * y + 2) * 32 + r; if (i == 3) return x * 32 + r; }
        return -1; }
    const int id = bx + i * G; return id < 1024 ? id : -1;
}
struct AttnPtrs { const unsigned short *QA, *KA, *VA, *QB, *KB, *VB, *QC, *KC, *VC; unsigned short* Y; float* stash; const float *lam_p, *subln; float lam_init; int seq;
                  const float *gqA, *gkA, *gqB, *gkB, *gqC, *gkC; };
__device__ __forceinline__ float wave_max(float v) {
#pragma unroll
    for (int o = 1; o < 64; o <<= 1) v = fmaxf(v, __shfl_xor(v, o));
    return v;
}
constexpr float BND_LIM = 64.f;
template <int D> __device__ __forceinline__ bool score_bounded(const float* gq, const float* gk, int lane) {
    float mq = 0.f, mk = 0.f;
#pragma unroll
    for (int i = 0; i < (D + 63) / 64; ++i) { const int j = lane + 64 * i; if (j < D) { mq = fmaxf(mq, fabsf(gq[j])); mk = fmaxf(mk, fabsf(gk[j])); } }
    const float b = wave_max(mq) * wave_max(mk) * (__builtin_sqrtf((float)D) * 1.4426950408889634f * 1.01f);
    return __builtin_amdgcn_readfirstlane((int)(b <= BND_LIM)) != 0;
}
__device__ __forceinline__ void store_o_bf16(const att::f32x16 (&o)[4], unsigned short* Yw, int r32, int hi) {
#pragma unroll
    for (int r = 0; r < 16; ++r) { const int orow = att::crow(r, hi);
#pragma unroll
        for (int d0 = 0; d0 < 4; ++d0) Yw[(size_t)orow * DM + d0 * 32 + r32] = (unsigned short)(cvtpk2(o[d0][r], 0.f) & 0xffffu); }
}
#ifndef ATT_BND
#define ATT_BND 1
#endif
#ifndef C_BND_DBL
#define C_BND_DBL 0
#endif
#ifndef C_BND_QL
#define C_BND_QL (C_BND_DBL ? 1 : CQL_PARK_BND)
#endif
#ifndef CQL_PARK_BND
#define CQL_PARK_BND CQL_PARK
#endif
#ifndef ATT16
#define ATT16 3
#endif
__device__ __forceinline__ void store_o16(const att::a16::f32x4 (&o)[2][8], unsigned short* Yw, int c16, int g4) {
#pragma unroll
    for (int qg = 0; qg < 2; ++qg)
#pragma unroll
        for (int r = 0; r < 4; ++r)
#pragma unroll
            for (int cb = 0; cb < 8; ++cb) Yw[(size_t)(qg * 16 + 4 * g4 + r) * DM + cb * 16 + c16] = (unsigned short)(cvtpk2(o[qg][cb][r], 0.f) & 0xffffu);
}
__device__ __forceinline__ void attn_phase(const Frame& F, const AttnPtrs& T, char* lds) {
    for (int i = 0;; ++i) {
        const int id = attn_unit_id(F.G, (int)blockIdx.x, i); if (id < 0) break;
        const int lane = fresh_lane(), wid = F.wave, tid = wid * 64 + lane;
        att::f32x16 o[4];
#ifndef ATT_MASK
#define ATT_MASK 7
#endif
        if (id < 256) { if constexpr ((ATT_MASK & 1) != 0) {
            const int h = id >> 5, t0 = (id & 31) * 256;
            float s1 = T.lam_p[lane] * T.lam_p[64 + lane], s2 = T.lam_p[128 + lane] * T.lam_p[192 + lane];
            s1 = wave_sum(s1); s2 = wave_sum(s2);
            const float lam = __builtin_amdgcn_exp2f(s1 * 1.4426950408889634f) - __builtin_amdgcn_exp2f(s2 * 1.4426950408889634f) + T.lam_init;
            f32x4* st4 = (f32x4*)(T.stash + (size_t)blockIdx.x * 32768 + tid * 64);
            const bool bnd = ATT_BND && score_bounded<64>(T.gqB, T.gkB, lane);
            if ((ATT16 & 1) != 0 && bnd) {
                att::a16::f32x4 o6[2][8]; const int c16 = lane & 15, g4 = lane >> 4;
                att::a16::attn_pass16<2, 1024, 1024, 1024>(T.QB + (size_t)t0 * 1024 + (2 * h) * 64, T.KB + (2 * h) * 64, T.VB + h * 128, T.seq, lds, o6, F.wave);
#pragma unroll
                for (int qg = 0; qg < 2; ++qg)
#pragma unroll
                    for (int cb = 0; cb < 8; ++cb) st4[qg * 8 + cb] = o6[qg][cb];
                asm volatile("" ::: "memory");
                att::a16::attn_pass16<2, 1024, 1024, 1024>(T.QB + (size_t)t0 * 1024 + (2 * h + 1) * 64, T.KB + (2 * h + 1) * 64, T.VB + h * 128, T.seq, lds, o6, F.wave);
                float li_ = T.lam_init; asm volatile("" : "+s"(li_)); const float post = 1.0f - li_;
                float gn[8];
#pragma unroll
                for (int cb = 0; cb < 8; ++cb) gn[cb] = T.subln[cb * 16 + c16] * post;
#pragma unroll
                for (int qg = 0; qg < 2; ++qg) { f32x4 s1v[8];
#pragma unroll
                    for (int cb = 0; cb < 8; ++cb) s1v[cb] = st4[qg * 8 + cb];
#pragma unroll
                    for (int r = 0; r < 4; ++r) { float q = 0.f;
#pragma unroll
                        for (int cb = 0; cb < 8; ++cb) { const float v = s1v[cb][r] - lam * o6[qg][cb][r]; o6[qg][cb][r] = v; q += v * v; }
                        q += __shfl_xor(q, 1); q += __shfl_xor(q, 2); q += __shfl_xor(q, 4); q += __shfl_xor(q, 8);
                        const float rstd = rsqrtf(q * (1.0f / 128.0f) + EPS);
#pragma unroll
                        for (int cb = 0; cb < 8; ++cb) o6[qg][cb][r] = o6[qg][cb][r] * rstd * gn[cb]; }
                    asm volatile("" ::: "memory"); }
                store_o16(o6, T.Y + (size_t)(t0 + wid * 32) * DM + 1536 + h * 128, c16, g4);
            } else {
            if ((ATT16 & 1) == 0 && bnd) ATT_B_PASS_BND(T.QB + (size_t)t0 * 1024 + (2 * h) * 64, T.KB + (2 * h) * 64, T.VB + h * 128, T.seq, lds, att::THRL, o, F.wave);
            else ATT_B_PASS(T.QB + (size_t)t0 * 1024 + (2 * h) * 64, T.KB + (2 * h) * 64, T.VB + h * 128, T.seq, lds, att::THRL, o, F.wave);
#pragma unroll
            for (int d0 = 0; d0 < 4; ++d0)
#pragma unroll
                for (int rg = 0; rg < 4; ++rg) st4[d0 * 4 + rg] = (f32x4){o[d0][4 * rg], o[d0][4 * rg + 1], o[d0][4 * rg + 2], o[d0][4 * rg + 3]};
            asm volatile("" ::: "memory");
            if ((ATT16 & 1) == 0 && bnd) ATT_B_PASS_BND(T.QB + (size_t)t0 * 1024 + (2 * h + 1) * 64, T.KB + (2 * h + 1) * 64, T.VB + h * 128, T.seq, lds, att::THRL, o, F.wave);
            else ATT_B_PASS(T.QB + (size_t)t0 * 1024 + (2 * h + 1) * 64, T.KB + (2 * h + 1) * 64, T.VB + h * 128, T.seq, lds, att::THRL, o, F.wave);
            float li_ = T.lam_init; asm volatile("" : "+s"(li_)); const float post = 1.0f - li_;
            float g[4];
#pragma unroll
            for (int d0 = 0; d0 < 4; ++d0) g[d0] = T.subln[d0 * 32 + (fresh_lane() & 31)] * post;
#pragma unroll
            for (int rg = 0; rg < 4; ++rg) { f32x4 s1v[4];
#pragma unroll
                for (int d0 = 0; d0 < 4; ++d0) s1v[d0] = st4[d0 * 4 + rg];
#pragma unroll
                for (int k = 0; k < 4; ++k) { const int r = 4 * rg + k; float q = 0.f;
#pragma unroll
                    for (int d0 = 0; d0 < 4; ++d0) { const float v = s1v[d0][k] - lam * o[d0][r]; o[d0][r] = v; q += v * v; }
                    q += __shfl_xor(q, 1); q += __shfl_xor(q, 2); q += __shfl_xor(q, 4); q += __shfl_xor(q, 8); q += __shfl_xor(q, 16);
                    const float rstd = rsqrtf(q * (1.0f / 128.0f) + EPS);
#pragma unroll
                    for (int d0 = 0; d0 < 4; ++d0) o[d0][r] = o[d0][r] * rstd * g[d0]; }
                asm volatile("" ::: "memory"); }
            { const int fl_ = fresh_lane(); store_o_bf16(o, T.Y + (size_t)(t0 + wid * 32) * DM + 1536 + h * 128, fl_ & 31, fl_ >> 5); } }
        } } else if (id < 640) { if constexpr ((ATT_MASK & 2) != 0) {
            const int a = id - 256, kvg = a / 96, rem = a - kvg * 96, h = kvg * 3 + (rem >> 5), t0 = (rem & 31) * 256;
            const bool bndA = ATT_BND && score_bounded<128>(T.gqA, T.gkA, lane);
            if ((ATT16 & 2) != 0 && bndA) {
                att::a16::f32x4 o6[2][8];
                att::a16::attn_pass16<4, 1536, 512, 512>(T.QA + (size_t)t0 * 1536 + h * 128, T.KA + kvg * 128, T.VA + kvg * 128, T.seq, lds, o6, F.wave);
                store_o16(o6, T.Y + (size_t)(t0 + wid * 32) * DM + h * 128, lane & 15, lane >> 4);
            } else {
            if ((ATT16 & 2) == 0 && bndA) att::attn_pass<8, ATT_SD_A, 0, true, ATT_NSLOT, 1536, 512, 512, true>(T.QA + (size_t)t0 * 1536 + h * 128, T.KA + kvg * 128, T.VA + kvg * 128, T.seq, lds, att::THRL, o, F.wave);
            else att::attn_pass<8, ATT_SD_A, 0, true, ATT_NSLOT, 1536, 512, 512>(T.QA + (size_t)t0 * 1536 + h * 128, T.KA + kvg * 128, T.VA + kvg * 128, T.seq, lds, att::THRL, o, F.wave);
            { const int fl_ = fresh_lane(); store_o_bf16(o, T.Y + (size_t)(t0 + wid * 32) * DM + h * 128, fl_ & 31, fl_ >> 5); } }
        } } else { if constexpr ((ATT_MASK & 4) != 0) {
            const int c = id - 640, h = c >> 5, t0 = (c & 31) * 256;
            const bool bndC = ATT_BND && score_bounded<192>(T.gqC, T.gkC, lane);
            if ((ATT16 & 4) != 0 && bndC) {
                att::a16::f32x4 o6[2][8];
                att::a16::attn_pass16<6, 2304, 2304, 1536>(T.QC + (size_t)t0 * 2304 + h * 192, T.KC + h * 192, T.VC + h * 128, T.seq, lds, o6, F.wave);
                store_o16(o6, T.Y + (size_t)(t0 + wid * 32) * DM + 2560 + h * 128, lane & 15, lane >> 4);
            } else {
            if ((ATT16 & 4) == 0 && bndC) att::attn_pass<12, 1, C_BND_QL, C_BND_DBL, C_BND_DBL ? 3 : 2, 2304, 2304, 1536, true>(T.QC + (size_t)t0 * 2304 + h * 192, T.KC + h * 192, T.VC + h * 128, T.seq, lds, att::THRL, o, F.wave);
            else att::attn_pass<12, 1, CQL_PARK, false, 2, 2304, 2304, 1536>(T.QC + (size_t)t0 * 2304 + h * 192, T.KC + h * 192, T.VC + h * 128, T.seq, lds, att::THRL, o, F.wave);
            { const int fl_ = fresh_lane(); store_o_bf16(o, T.Y + (size_t)(t0 + wid * 32) * DM + 2560 + h * 128, fl_ & 31, fl_ >> 5); } }
        } }
    }
}

#ifndef PROBE_GEMM
#define PROBE_GEMM 0
#endif
#ifndef Q_INPROJ
#define Q_INPROJ 4
#define Q_CUP 1
#define Q_ATTN 2
#define Q_GATEUP 4
#endif
__global__ void __launch_bounds__(NWAVES * 64, 2) hybrid_fwd(Args args) {
    extern __shared__ __attribute__((aligned(16))) unsigned char lds[];
    Frame F;
    F.lds = (LAS unsigned char*)lds; F.MISC = (volatile LAS unsigned*)(F.lds + MISC_OFF);
    F.wave = __builtin_amdgcn_readfirstlane((int)(threadIdx.x >> 6));
    F.G = gridDim.x; { const int bx = blockIdx.x; F.vcu = (F.G % 8 == 0) ? (bx % 8) * (F.G / 8) + bx / 8 : bx; }
    unsigned char* ws = args.ws;
    for (int u = (int)threadIdx.x; u < (LDS_BYTES - MISC_OFF) / 4; u += NWAVES * 64) ((LAS unsigned*)(F.lds + MISC_OFF))[u] = 0u;
    __syncthreads();
    XcdBarrier bar; bar.bar = (unsigned*)(ws + WS_CTL) + CW_BAR; bar.x = 0; bar.st = nullptr;
    if (!MK_PER_PHASE) bar = xcd_barrier_post((unsigned*)(ws + WS_CTL) + CW_BAR, F.MISC + 8);
    const int lo = args.ph_lo, hi = args.ph_hi;
#ifndef PH_MASK
#define PH_MASK 0x1ff
#endif
#define PK(b) (((PH_MASK) >> (b)) & 1)
#ifndef PH_REP
#define PH_REP 0
#endif
#define REP(b) (1 + (((PH_REP) >> (b)) & 1))
#define IN(k) (lo <= (k) && (k) < hi)
#ifndef BAR_STEAL
#define BAR_STEAL 0
#endif
#define SEAM(k) do { if (!MK_PER_PHASE && IN(k) && IN((k) + 1)) { if (BAR_STEAL) xcd_barrier_steal(bar, F, args, ws); else xcd_barrier(bar); } } while (0)
    typedef unsigned short bf;
#define WSP(T, off) ((T*)(GAS T*)(wsl + (off)))
#define LOCAL_PTRS GAS unsigned char* wsl = (GAS unsigned char*)ws; asm volatile("" : "+s"(wsl)); \
    float* tcC = WSP(float, WS_TCC); float* tsC = WSP(float, WS_TSC); float* tcB = WSP(float, WS_TCB); float* tsB = WSP(float, WS_TSB); \
    bf* XN = WSP(bf, WS_XN); bf* QA = WSP(bf, WS_QA); bf* KA = WSP(bf, WS_KA); bf* VA = WSP(bf, WS_VA); bf* QB = WSP(bf, WS_QB); bf* KB = WSP(bf, WS_KB); bf* VB = WSP(bf, WS_VB); \
    bf* CQL = WSP(bf, WS_CQL); bf* CKVL = WSP(bf, WS_CKVL); float* CKR = WSP(float, WS_CKR); bf* QC = WSP(bf, WS_QC); bf* KC = WSP(bf, WS_KC); bf* VC = WSP(bf, WS_VC); \
    bf* Y = WSP(bf, WS_Y); bf* ACT = WSP(bf, WS_ACTB); float* STASH = WSP(float, WS_STASH); \
    unsigned char* wl = (unsigned char*)(wsl + WS_W0 + (size_t)l * W_LAYER); float* SSQ = WSP(float, WS_SSQ) + (size_t)l * 3 * SEQ; float* SSQH = WSP(float, WS_SSQ) + 9 * SEQ; \
    (void)tcC; (void)tsC; (void)tcB; (void)tsB; (void)XN; (void)QA; (void)KA; (void)VA; (void)QB; (void)KB; (void)VB; (void)CQL; (void)CKVL; (void)CKR; (void)QC; (void)KC; (void)VC; (void)Y; (void)ACT; (void)STASH; (void)wl; (void)SSQ; (void)SSQH
    PG8_LAS float* EP = (PG8_LAS float*)(F.lds + EPI_OFF);
    PG8_LAS unsigned char* ring = (PG8_LAS unsigned char*)(F.lds + RING_OFF);

    for (int rep_ = 0; rep_ < REP(0); ++rep_) if (PK(0) && IN(0)) { const int l = 0; LOCAL_PTRS;
        {
            cvt_matrix<1>(F, args.in[2] + (size_t)l * DM * NIN, DM, NIN, (bf*)(wl + W_IN), args.in[1] + l * DM);
            cvt_matrix<2>(F, args.in[11] + (size_t)l * 1024 * 2304, 1024, 2304, (bf*)(wl + W_QUP), args.in[9] + l * 1024);
            cvt_matrix<0>(F, args.in[12] + (size_t)l * 512 * 3072, 512, 3072, (bf*)(wl + W_KVUP), args.in[10] + l * 512);
            cvt_matrix<0>(F, args.in[15] + (size_t)l * DM * DM, DM, DM, (bf*)(wl + W_OUT), nullptr); }
        rope_tables(F, tcC, tsC, tcB, tsB);
        cast_rows(F, args.in[0], XN, SSQH);
    }
    SEAM(0);
    for (int l = 0; l < DEPTH; ++l) {
        const int pb = 1 + 8 * l;
        if (PK(1) && IN(pb + 0)) { __builtin_amdgcn_s_waitcnt(0); LOCAL_PTRS;
            pg8::Gemm g{XN, (const bf*)(wl + W_IN), SEQ, NINP, DM}; pg8::StaticOrder S; S.init(SEQ, NINP, F.G, (int)blockIdx.x);
            pg8::EpiInProj E{QA, KA, VA, QB, KB, VB, CQL, CKVL, CKR, SSQ, SSQ + SEQ, SSQ + 2 * SEQ,
                             args.in[3] + l * 128, args.in[4] + l * 128, args.in[5] + l * 64, args.in[6] + l * 64, tcC, tsC, tcB, tsB, EP, SSQH + (size_t)(2 * l) * SEQ};
            pg8::gemm_phase<pg8::EpiInProj, pg8::StaticOrder, true, true>(ring, g, S, E, F.wave);
            cvt_steal(F, args, ws, (fresh_bx() >= 160 && F.G == 256) ? Q_INPROJ : 0, 0);
            if (PROBE_GEMM == 2) { float* SD_ = (float*)(ws + WS_SSQ) + 6 * SEQ; pg8::EpiInProj E2 = E; E2.SSQ_Q = SD_; E2.SSQ_KV = SD_ + SEQ; E2.SSQ_KR = SD_ + 2 * SEQ; pg8::gemm_phase<pg8::EpiInProj, pg8::StaticOrder, true, true>(ring, g, S, E2, F.wave); }
        }
        SEAM(pb + 0);
        for (int rep_ = 0; rep_ < REP(2); ++rep_) if (PK(2) && IN(pb + 1)) { __builtin_amdgcn_s_waitcnt(0); LOCAL_PTRS;
            { pg8::Gemm g{CQL, (const bf*)(wl + W_QUP), SEQ, 3072, 1024}; pg8::StaticOrder S; S.init(SEQ, 3072, F.G, (int)blockIdx.x);
              pg8::EpiQUp E{QC, SSQ, args.in[13] + l * 192, tcC, tsC, EP};
              pg8::gemm_phase<pg8::EpiQUp, pg8::StaticOrder, true, true>(ring, g, S, E, F.wave); }
            { pg8::Gemm g{CKVL, (const bf*)(wl + W_KVUP), SEQ, 3072, 512}; pg8::StaticOrder S; S.init(SEQ, 3072, F.G, (int)blockIdx.x);
              pg8::EpiKVUp E{KC, VC, SSQ + SEQ, SSQ + 2 * SEQ, CKR, args.in[14] + l * 192, tcC, tsC, EP};
              pg8::gemm_phase<pg8::EpiKVUp, pg8::StaticOrder, true, true>(ring, g, S, E, F.wave); }
            cvt_steal(F, args, ws, (fresh_bx() >= 128 && F.G == 256) ? Q_CUP : 0, 0);
        }
        SEAM(pb + 1);
        for (int rep_ = 0; rep_ < REP(3); ++rep_) if (PK(3) && IN(pb + 2)) { __builtin_amdgcn_s_waitcnt(0); LOCAL_PTRS;
            const AttnPtrs T{QA, KA, VA, QB, KB, VB, QC, KC, VC, Y, STASH, args.in[7] + l * 256, args.in[8] + l * 128, args.lam_init[l], args.seq,
                             args.in[3] + l * 128, args.in[4] + l * 128, args.in[5] + l * 64, args.in[6] + l * 64, args.in[13] + l * 192, args.in[14] + l * 192};
            attn_phase(F, T, (char*)lds + RING_OFF);
            cvt_steal(F, args, ws, ((fresh_bx() & 1) == 0 && F.G == 256) ? Q_ATTN : 0, 0);
        }
        SEAM(pb + 2);
        if (PK(4) && IN(pb + 3)) { __builtin_amdgcn_s_waitcnt(0); LOCAL_PTRS;
            pg8::Gemm g{Y, (const bf*)(wl + W_OUT), SEQ, DM, DM}; pg8::StaticOrder S; S.init(SEQ, DM, F.G, (int)blockIdx.x);
            pg8::EpiResid E{XN, nullptr, DM, SSQH + (size_t)(2 * l + 1) * SEQ};
            pg8::gemm_phase<pg8::EpiResid, pg8::StaticOrder, true, true>(ring, g, S, E, F.wave);
            cvt_steal(F, args, ws, 0, (l == 0 ? 0 : Q_END_B) + 2 * QI_GATE);
        }
        SEAM(pb + 3);
        for (int rep_ = 0; rep_ < REP(6); ++rep_) if (PK(6) && IN(pb + 5)) { __builtin_amdgcn_s_waitcnt(0); LOCAL_PTRS;
            pg8::Gemm g{XN, (const bf*)(wl + W_GU), SEQ, 2 * FF, DM}; pg8::StaticOrder S; S.init(SEQ, 2 * FF, F.G, (int)blockIdx.x);
            pg8::EpiGateUp E{ACT, FF, SSQH + (size_t)(2 * l + 1) * SEQ};
            pg8::gemm_phase<pg8::EpiGateUp, pg8::StaticOrder, true, true>(ring, g, S, E, F.wave);
            cvt_steal(F, args, ws, (fresh_bx() >= 192 && F.G == 256) ? Q_GATEUP : 0, l == 0 ? Q_END_A : Q_END_C);
        }
        SEAM(pb + 5);
        if (PK(7) && IN(pb + 6)) { __builtin_amdgcn_s_waitcnt(0); LOCAL_PTRS;
            pg8::Gemm g{ACT, (const bf*)(wl + W_DOWN), SEQ, DM, FF}; pg8::StaticOrder S; S.init(SEQ, DM, F.G, (int)blockIdx.x);
            pg8::EpiResid E{XN, (l + 1 < DEPTH) ? nullptr : args.out, DM, SSQH + (size_t)(2 * l + 2) * SEQ};
            pg8::gemm_phase<pg8::EpiResid, pg8::StaticOrder, true, true>(ring, g, S, E, F.wave);
            if (l == 0) cvt_steal(F, args, ws, 0, Q_END_B);
        }
        if (l + 1 < DEPTH) SEAM(pb + 6);
    }
#undef IN
#undef SEAM
#undef PK
#undef LOCAL_PTRS
#undef WSP
}

extern "C" void kernel_launch(void* const* d_in, const int* in_sizes, int n_in, void* d_out, int out_size, void* d_ws, size_t ws_size, hipStream_t stream) {
    static int grid = 0;
    if (grid == 0) {
        if (n_in != 20 || in_sizes[0] != SEQ * DM || out_size != SEQ * DM || ws_size < WS_END) {
            fprintf(stderr, "kernel_launch: unexpected shapes: n_in %d in0 %d out %d ws %zu (need %zu); nothing launched\n", n_in, n_in > 0 ? in_sizes[0] : -1, out_size, ws_size, (size_t)WS_END); grid = -1; return; }
        int dev = 0, cus = 0, per_cu = 0;
        if (hipGetDevice(&dev) != hipSuccess || hipDeviceGetAttribute(&cus, hipDeviceAttributeMultiprocessorCount, dev) != hipSuccess) { fprintf(stderr, "kernel_launch: device query failed\n"); grid = -1; return; }
        if (hipFuncSetAttribute((const void*)hybrid_fwd, hipFuncAttributeMaxDynamicSharedMemorySize, LDS_BYTES) != hipSuccess) { fprintf(stderr, "kernel_launch: hipFuncSetAttribute failed\n"); grid = -1; return; }
        if (hipOccupancyMaxActiveBlocksPerMultiprocessor(&per_cu, (const void*)hybrid_fwd, NWAVES * 64, LDS_BYTES) != hipSuccess || per_cu < 1)
            fprintf(stderr, "kernel_launch: note: occupancy query reports %d workgroups per CU\n", per_cu);
        (void)hipGetLastError();
        grid = cus;
    }
    if (grid < 0) return;
    if (hipMemsetAsync((char*)d_ws + WS_CTL, 0, CTL_ZERO_BYTES, stream) != hipSuccess) { fprintf(stderr, "kernel_launch: hipMemsetAsync failed\n"); return; }
    Args a{};
    for (int i = 0; i < 20; ++i) a.in[i] = (const float*)d_in[i];
    a.out = (float*)d_out; a.ws = (unsigned char*)d_ws;
    a.seq = SEQ; a.pad = 0; a.lam_init[0] = 0.2f; a.lam_init[1] = (float)(0.8 - 0.6 * 0.74081822068171786607);
#if MK_PER_PHASE
    for (int p = 0; p < N_PHASES; ++p) { a.ph_lo = p; a.ph_hi = p + 1; hipLaunchKernelGGL(hybrid_fwd, dim3(grid), dim3(NWAVES * 64), LDS_BYTES, stream, a); }
#else
    a.ph_lo = 0; a.ph_hi = N_PHASES;
    hipLaunchKernelGGL(hybrid_fwd, dim3(grid), dim3(NWAVES * 64), LDS_BYTES, stream, a);
#endif
    const hipError_t le = hipPeekAtLastError();
    if (le != hipSuccess) fprintf(stderr, "kernel_launch: launch failed: %s\n", hipGetErrorName(le));
}
```
